# Optimizing an MI355X kernel written in HIP

```python
import math
import jax, jax.numpy as jnp
from jax import lax
import numpy as np

D_MODEL = 1024
BATCH = 4
SEQ = 8192
DEPTH = 4

N_MIXERS = 2
N_A = (DEPTH + 1) // 2
N_B = DEPTH // 2
NORM_EPS = 1e-6
D_RNN = D_MODEL
RG_HEADS = 8
RG_BW = D_RNN // RG_HEADS
RG_CONV_W = 4
RG_C = 8.0
RG_RAD_MIN = 0.9
RG_RAD_MAX = 0.999
D_S5 = D_MODEL
S5_GC = 16
S5_G = D_S5 // S5_GC
S5_P = 64
S5_DT_MIN = 0.001
S5_DT_MAX = 0.1
D_FF = 3 * D_MODEL
FFN_CONV_W = 3

kernel_name = "hybrid_rglru_s5_convffn_trunk"


def _rmsnorm(x, g):
    x32 = x.astype(jnp.float32)
    var = jnp.mean(x32 * x32, axis=-1, keepdims=True)
    return (x32 * lax.rsqrt(var + NORM_EPS) * g.astype(jnp.float32)).astype(x.dtype)


def _causal_dwconv(x, w, b):
    k_w = w.shape[0]
    s = x.shape[1]
    xp = jnp.pad(x, ((0, 0), (k_w - 1, 0), (0, 0)))
    out = b
    for k in range(k_w):
        out = out + xp[:, k:k + s, :] * w[k]
    return out


def _real_scan_combine(e1, e2):
    a1, b1 = e1
    a2, b2 = e2
    return a1 * a2, a2 * b1 + b2


def _complex_scan_combine(e1, e2):
    a1r, a1i, b1r, b1i = e1
    a2r, a2i, b2r, b2i = e2
    ar = a2r * a1r - a2i * a1i
    ai = a2r * a1i + a2i * a1r
    br = a2r * b1r - a2i * b1i + b2r
    bi = a2r * b1i + a2i * b1r + b2i
    return ar, ai, br, bi


def _rglru_mixer(h, w_in, conv_w, conv_b, w_a, b_a, w_x, b_x, lam, w_out):
    bsz, s, _ = h.shape
    xg = h @ w_in
    xr, gate = xg[..., :D_RNN], xg[..., D_RNN:]
    xr = _causal_dwconv(xr, conv_w, conv_b)
    xh = xr.reshape(bsz, s, RG_HEADS, RG_BW)
    r = jax.nn.sigmoid(jnp.einsum('bshi,hij->bshj', xh, w_a) + b_a).reshape(bsz, s, D_RNN)
    ig = jax.nn.sigmoid(jnp.einsum('bshi,hij->bshj', xh, w_x) + b_x).reshape(bsz, s, D_RNN)
    log_a = -RG_C * r.astype(jnp.float32) * jax.nn.softplus(-lam.astype(jnp.float32))
    a = jnp.exp(log_a)
    mult = jnp.sqrt(-jnp.expm1(2.0 * log_a))
    bterm = mult * (ig * xr).astype(jnp.float32)
    _, hs = lax.associative_scan(_real_scan_combine, (a, bterm), axis=1)
    y = hs.astype(h.dtype) * jax.nn.gelu(gate)
    return y @ w_out


def _s5_mixer(h, w_in, a_re, a_im, log_dt, b_re, b_im, c_re, c_im, d, w_glu, w_out):
    bsz, s, _ = h.shape
    u = h @ w_in
    ug = u.reshape(bsz, s, S5_G, S5_GC).astype(jnp.float32)
    ar = a_re.astype(jnp.float32)
    ai = a_im.astype(jnp.float32)
    dt = jnp.exp(log_dt.astype(jnp.float32))[:, None]
    mag = jnp.exp(ar * dt)
    abr = mag * jnp.cos(ai * dt)
    abi = mag * jnp.sin(ai * dt)
    ur, ui = abr - 1.0, abi
    den = ar * ar + ai * ai
    wr = (ur * ar + ui * ai) / den
    wi = (ui * ar - ur * ai) / den
    br32, bi32 = b_re.astype(jnp.float32), b_im.astype(jnp.float32)
    bbr = wr[..., None] * br32 - wi[..., None] * bi32
    bbi = wr[..., None] * bi32 + wi[..., None] * br32
    bu_r = jnp.einsum('bsgc,gpc->bsgp', ug, bbr)
    bu_i = jnp.einsum('bsgc,gpc->bsgp', ug, bbi)
    a_r = jnp.broadcast_to(abr, (1, s, S5_G, S5_P))
    a_i = jnp.broadcast_to(abi, (1, s, S5_G, S5_P))
    _, _, hr, hi = lax.associative_scan(_complex_scan_combine, (a_r, a_i, bu_r, bu_i), axis=1)
    y = (jnp.einsum('bsgp,gcp->bsgc', hr, c_re.astype(jnp.float32))
         - jnp.einsum('bsgp,gcp->bsgc', hi, c_im.astype(jnp.float32)))
    y = y.reshape(bsz, s, D_S5).astype(h.dtype) + d * u
    g = jax.nn.gelu(y)
    gl = g @ w_glu
    out = gl[..., :D_S5] * jax.nn.sigmoid(gl[..., D_S5:])
    return out @ w_out


def _conv_ffn(h, w_up, conv_w, conv_b, w_down):
    up = _causal_dwconv(h @ w_up, conv_w, conv_b)
    return (jax.nn.gelu(up[..., :D_FF]) * up[..., D_FF:]) @ w_down


def setup_inputs(seed: int = 0) -> dict:
    key = jax.random.key(seed)
    ks = jax.random.split(key, 32)
    f32 = jnp.float32
    nrm = lambda k, shp, sc: jax.random.normal(k, shp, f32) * sc
    x = jax.random.normal(ks[0], (BATCH, SEQ, D_MODEL), f32)
    norm_mix_g = 1.0 + nrm(ks[1], (DEPTH, D_MODEL), 0.02)
    norm_ffn_g = 1.0 + nrm(ks[2], (DEPTH, D_MODEL), 0.02)
    norm_final_g = 1.0 + nrm(ks[3], (D_MODEL,), 0.02)
    rg_w_in = nrm(ks[4], (N_A, D_MODEL, 2 * D_RNN), D_MODEL ** -0.5)
    rg_conv_w = nrm(ks[5], (N_A, RG_CONV_W, D_RNN), RG_CONV_W ** -0.5)
    rg_conv_b = nrm(ks[6], (N_A, D_RNN), 0.01)
    rg_w_a = nrm(ks[7], (N_A, RG_HEADS, RG_BW, RG_BW), RG_BW ** -0.5)
    rg_b_a = nrm(ks[8], (N_A, RG_HEADS, RG_BW), 0.01)
    rg_w_x = nrm(ks[9], (N_A, RG_HEADS, RG_BW, RG_BW), RG_BW ** -0.5)
    rg_b_x = nrm(ks[10], (N_A, RG_HEADS, RG_BW), 0.01)
    a0 = jnp.sqrt(jax.random.uniform(ks[11], (N_A, D_RNN), f32,
                                     RG_RAD_MIN ** 2, RG_RAD_MAX ** 2))
    rg_lambda = jnp.log(a0) - jnp.log1p(-a0)
    rg_w_out = nrm(ks[12], (N_A, D_RNN, D_MODEL), D_RNN ** -0.5)
    s5_w_in = nrm(ks[13], (N_B, D_MODEL, D_S5), D_MODEL ** -0.5)
    s5_a_re = -0.5 + nrm(ks[14], (N_B, S5_G, S5_P), 0.01)
    s5_a_im = (math.pi * jnp.arange(S5_P, dtype=f32))[None, None, :] + nrm(ks[15], (N_B, S5_G, S5_P), 0.01)
    s5_log_dt = jax.random.uniform(ks[16], (N_B, S5_G), f32,
                                   math.log(S5_DT_MIN), math.log(S5_DT_MAX))
    s5_b_re = nrm(ks[17], (N_B, S5_G, S5_P, S5_GC), (2 * S5_GC) ** -0.5)
    s5_b_im = nrm(ks[18], (N_B, S5_G, S5_P, S5_GC), (2 * S5_GC) ** -0.5)
    s5_c_re = nrm(ks[19], (N_B, S5_G, S5_GC, S5_P), (0.5 * S5_P) ** -0.5)
    s5_c_im = nrm(ks[20], (N_B, S5_G, S5_GC, S5_P), (0.5 * S5_P) ** -0.5)
    s5_d = nrm(ks[21], (N_B, D_S5), 1.0)
    s5_w_glu = nrm(ks[22], (N_B, D_S5, 2 * D_S5), D_S5 ** -0.5)
    s5_w_out = nrm(ks[23], (N_B, D_S5, D_MODEL), D_S5 ** -0.5)
    ffn_w_up = nrm(ks[24], (DEPTH, D_MODEL, 2 * D_FF), D_MODEL ** -0.5)
    ffn_conv_w = nrm(ks[25], (DEPTH, FFN_CONV_W, 2 * D_FF), FFN_CONV_W ** -0.5)
    ffn_conv_b = nrm(ks[26], (DEPTH, 2 * D_FF), 0.01)
    ffn_w_down = nrm(ks[27], (DEPTH, D_FF, D_MODEL), D_FF ** -0.5)
    return {"x": x, "norm_mix_g": norm_mix_g, "norm_ffn_g": norm_ffn_g, "norm_final_g": norm_final_g,
            "rg_w_in": rg_w_in, "rg_conv_w": rg_conv_w, "rg_conv_b": rg_conv_b,
            "rg_w_a": rg_w_a, "rg_b_a": rg_b_a, "rg_w_x": rg_w_x, "rg_b_x": rg_b_x,
            "rg_lambda": rg_lambda, "rg_w_out": rg_w_out,
            "s5_w_in": s5_w_in, "s5_a_re": s5_a_re, "s5_a_im": s5_a_im, "s5_log_dt": s5_log_dt,
            "s5_b_re": s5_b_re, "s5_b_im": s5_b_im, "s5_c_re": s5_c_re, "s5_c_im": s5_c_im,
            "s5_d": s5_d, "s5_w_glu": s5_w_glu, "s5_w_out": s5_w_out,
            "ffn_w_up": ffn_w_up, "ffn_conv_w": ffn_conv_w, "ffn_conv_b": ffn_conv_b,
            "ffn_w_down": ffn_w_down}


def reference(x, norm_mix_g, norm_ffn_g, norm_final_g,
              rg_w_in, rg_conv_w, rg_conv_b, rg_w_a, rg_b_a, rg_w_x, rg_b_x, rg_lambda, rg_w_out,
              s5_w_in, s5_a_re, s5_a_im, s5_log_dt, s5_b_re, s5_b_im, s5_c_re, s5_c_im,
              s5_d, s5_w_glu, s5_w_out,
              ffn_w_up, ffn_conv_w, ffn_conv_b, ffn_w_down):
    h = x
    for i in range(DEPTH):
        hn = _rmsnorm(h, norm_mix_g[i])
        j = i // N_MIXERS
        if i % N_MIXERS == 0:
            mix = _rglru_mixer(hn, rg_w_in[j], rg_conv_w[j], rg_conv_b[j], rg_w_a[j], rg_b_a[j],
                               rg_w_x[j], rg_b_x[j], rg_lambda[j], rg_w_out[j])
        else:
            mix = _s5_mixer(hn, s5_w_in[j], s5_a_re[j], s5_a_im[j], s5_log_dt[j], s5_b_re[j],
                            s5_b_im[j], s5_c_re[j], s5_c_im[j], s5_d[j], s5_w_glu[j], s5_w_out[j])
        h = h + mix.astype(h.dtype)
        hn = _rmsnorm(h, norm_ffn_g[i])
        h = h + _conv_ffn(hn, ffn_w_up[i], ffn_conv_w[i], ffn_conv_b[i], ffn_w_down[i]).astype(h.dtype)
    return _rmsnorm(h, norm_final_g)
```

```cpp
#include <hip/hip_runtime.h>
#include <hip/hip_cooperative_groups.h>
#include <cstdio>
#include <cstdint>
namespace cg = cooperative_groups;

namespace pg8 {
#define PG8_LAS __attribute__((address_space(3)))
typedef unsigned short bf16_t;
typedef short bf16x8 __attribute__((ext_vector_type(8)));
typedef float f32x4 __attribute__((ext_vector_type(4)));
typedef unsigned u32x4 __attribute__((ext_vector_type(4)));
typedef unsigned u32x2 __attribute__((ext_vector_type(2)));
constexpr int BM = 256, BK = 64, HALF = 128, HTB = HALF * BK * 2  , STAGE_BYTES = 8 * HTB, NXCD = 8, WGM = 4;

__host__ __device__ __forceinline__ int lds_byte(int r, int c) { const int st = (r >> 4) * 2 + (c >> 5), rr = r & 15, cc = c & 31, ob = rr * 64 + cc * 2; return st * 1024 + (ob ^ (((ob >> 9) & 1) << 5)); }
__host__ __device__ __forceinline__ void stage_rc(int b, int& R, int& C) { const int st = b / 1024, sb = b % 1024, swz = sb ^ (((sb >> 9) & 1) << 5); R = (st >> 1) * 16 + swz / 64; C = (st & 1) * 32 + (swz % 64) / 2; }
__host__ __device__ __forceinline__ int perm32(int rho) { const int n = rho >> 4, i = rho & 15; return 8 * (i >> 2) + 4 * n + (i & 3); }

struct Unit { int pm, pn, idx; };
struct Gemm { const bf16_t* A; const bf16_t* Bt; int M, N, K; };

struct StaticOrder {
    int nM, nN, nwg, G, c;
    __host__ __device__ void init(int M, int N, int G_, int c_) { nM = M / BM; nN = N / BM; nwg = nM * nN; G = G_; c = c_; }
    __host__ __device__ bool next(int i, Unit& u) const {
        const long L = (long)i * G + c; if (L >= nwg) return false;
        int wgid = (int)L; { const int q = nwg / NXCD, r = nwg % NXCD, xcd = wgid % NXCD, off = wgid / NXCD; wgid = (xcd < r ? xcd * (q + 1) : r * (q + 1) + (xcd - r) * q) + off; }
        const int nig = WGM * nN, gid = wgid / nig, fm = gid * WGM, gsz = (nM - fm) < WGM ? (nM - fm) : WGM;
        u.pm = fm + ((wgid % nig) % gsz); u.pn = (wgid % nig) / gsz; u.idx = i; return true;
    }
    __device__ __forceinline__ void a_ready(const Unit&) const {}
    __device__ __forceinline__ void done(const Unit&) const {}
};

__device__ __forceinline__ unsigned cvt_pk_bf16(float lo, float hi) { unsigned r; asm volatile("v_cvt_pk_bf16_f32 %0, %1, %2" : "=v"(r) : "v"(lo), "v"(hi)); return r; }
__device__ __forceinline__ float fsigmoid(float x) { return __builtin_amdgcn_rcpf(1.0f + __builtin_amdgcn_exp2f(-1.4426950408889634f * x)); }
__device__ __forceinline__ float gelu_t(float x) { const float y = x * (1.5957691216057308f + 0.0713548162726009f * x * x); return x * fsigmoid(y); }
__device__ __forceinline__ float bf_lo(unsigned w) { return __builtin_bit_cast(float, w << 16); }
__device__ __forceinline__ float bf_hi(unsigned w) { return __builtin_bit_cast(float, w & 0xffff0000u); }
typedef float f32x2 __attribute__((ext_vector_type(2)));
__device__ __forceinline__ f32x2 gelu_gate_pk(f32x2 v, f32x2 g) {
    const f32x2 z = v * ((v * v) * (-0.0713548162726009f * 1.4426950408889634f) + (-1.5957691216057308f * 1.4426950408889634f));
    f32x2 e; e.x = __builtin_amdgcn_exp2f(z.x); e.y = __builtin_amdgcn_exp2f(z.y);
    const f32x2 d = e + 1.0f;
    f32x2 r; r.x = __builtin_amdgcn_rcpf(d.x); r.y = __builtin_amdgcn_rcpf(d.y);
    return (v * g) * r;
}
__device__ __forceinline__ float dpp_prev1(float cur, float prev) {
    const int rot = __builtin_amdgcn_update_dpp(0, __builtin_bit_cast(int, prev), 0x121, 0xf, 0xf, false);
    return __builtin_bit_cast(float, __builtin_amdgcn_update_dpp(rot, __builtin_bit_cast(int, cur), 0x111, 0xf, 0xf, false));
}
__device__ __forceinline__ float dpp_prev2(float cur, float prev) {
    const int rot = __builtin_amdgcn_update_dpp(0, __builtin_bit_cast(int, prev), 0x122, 0xf, 0xf, false);
    return __builtin_bit_cast(float, __builtin_amdgcn_update_dpp(rot, __builtin_bit_cast(int, cur), 0x112, 0xf, 0xf, false));
}
__device__ __forceinline__ float row_rs(const float* rowsq, int row) {
    const f32x4* p = (const f32x4*)(rowsq + (size_t)row * 16);
    const f32x4 a = p[0], b = p[1], c = p[2], d = p[3];
    const float s = (((a[0] + a[1]) + (a[2] + a[3])) + ((b[0] + b[1]) + (b[2] + b[3]))) + (((c[0] + c[1]) + (c[2] + c[3])) + ((d[0] + d[1]) + (d[2] + d[3])));
    return __builtin_amdgcn_rsqf(s * (1.0f / 1024.0f) + 1e-6f);
}

__device__ __forceinline__ float row_ssq_part(const float* rowsq, int row, int fq) { const f32x4 a = *(const f32x4*)(rowsq + (size_t)row * 16 + 4 * fq); return (a[0] + a[1]) + (a[2] + a[3]); }
__device__ __forceinline__ float row_rs_fin(float s) { s += __shfl_xor(s, 16); s += __shfl_xor(s, 32); return __builtin_amdgcn_rsqf(s * (1.0f / 1024.0f) + 1e-6f); }


struct EpiRsBf16 {
    static constexpr bool PERM = true, AFTER_DRAIN = false, PERM_A = false;
    bf16_t* O0; bf16_t* O1; int split_pn; PG8_LAS const float* rsl;
    __device__ __forceinline__ void operator()(const f32x4 (&acc)[2][2][4][2], const Unit& u, int wr, int wc, int fr, int fq) const {
        const bool second = u.pn >= split_pn;
        bf16_t* base = second ? O1 : O0;
        const int col0 = (u.pn & 3) * BM + wc * 32 + 8 * fq;
        const int row0 = u.pm * BM + wr * 64 + fr;
#pragma unroll
        for (int ai = 0; ai < 2; ++ai)
#pragma unroll
            for (int m = 0; m < 4; ++m) {
                const int row = row0 + ai * HALF + m * 16;
                const float rs = rsl[u.idx * 256 + wr * 64 + fr + ai * HALF + m * 16];
                bf16_t* rowp = base + (size_t)row * 1024 + col0;
#pragma unroll
                for (int bj = 0; bj < 2; ++bj) {
                    f32x4 v0 = acc[ai][bj][m][0] * rs, v1 = acc[ai][bj][m][1] * rs;
                    if (second) {
#pragma unroll
                        for (int e = 0; e < 4; ++e) { v0[e] = gelu_t(v0[e]); v1[e] = gelu_t(v1[e]); }
                    }
                    u32x4 w; w.x = cvt_pk_bf16(v0[0], v0[1]); w.y = cvt_pk_bf16(v0[2], v0[3]); w.z = cvt_pk_bf16(v1[0], v1[1]); w.w = cvt_pk_bf16(v1[2], v1[3]);
                    *(u32x4*)(rowp + bj * HALF) = w;
                }
            }
    }
};

struct EpiResid {
    static constexpr bool PERM = true, AFTER_DRAIN = false, PERM_A = false;
    const float* xbase; bf16_t* HB; bf16_t* HL; float* rowsq;
    __device__ __forceinline__ void operator()(const f32x4 (&acc)[2][2][4][2], const Unit& u, int wr, int wc, int fr, int fq) const {
        const int col0 = u.pn * BM + wc * 32 + 8 * fq;
        const int row0 = u.pm * BM + wr * 64 + fr;
#pragma unroll
        for (int ai = 0; ai < 2; ++ai)
#pragma unroll
            for (int m = 0; m < 4; ++m) {
                const int row = row0 + ai * HALF + m * 16;
                const size_t off = (size_t)row * 1024 + col0;
                float ss = 0.f;
#pragma unroll
                for (int bj = 0; bj < 2; ++bj) {
                    const size_t o = off + bj * HALF;
                    f32x4 b0, b1;
                    if (xbase) { b0 = *(const f32x4*)(xbase + o); b1 = *(const f32x4*)(xbase + o + 4); }
                    else { const u32x4 hw = *(const u32x4*)(HB + o), lw = *(const u32x4*)(HL + o);
                           b0 = (f32x4){bf_lo(hw.x) + bf_lo(lw.x), bf_hi(hw.x) + bf_hi(lw.x), bf_lo(hw.y) + bf_lo(lw.y), bf_hi(hw.y) + bf_hi(lw.y)};
                           b1 = (f32x4){bf_lo(hw.z) + bf_lo(lw.z), bf_hi(hw.z) + bf_hi(lw.z), bf_lo(hw.w) + bf_lo(lw.w), bf_hi(hw.w) + bf_hi(lw.w)}; }
                    const f32x4 v0 = b0 + acc[ai][bj][m][0], v1 = b1 + acc[ai][bj][m][1];
                    ss += ((v0[0] * v0[0] + v0[1] * v0[1]) + (v0[2] * v0[2] + v0[3] * v0[3])) + ((v1[0] * v1[0] + v1[1] * v1[1]) + (v1[2] * v1[2] + v1[3] * v1[3]));
                    u32x4 h; h.x = cvt_pk_bf16(v0[0], v0[1]); h.y = cvt_pk_bf16(v0[2], v0[3]); h.z = cvt_pk_bf16(v1[0], v1[1]); h.w = cvt_pk_bf16(v1[2], v1[3]);
                    u32x4 l; l.x = cvt_pk_bf16(v0[0] - bf_lo(h.x), v0[1] - bf_hi(h.x)); l.y = cvt_pk_bf16(v0[2] - bf_lo(h.y), v0[3] - bf_hi(h.y));
                    l.z = cvt_pk_bf16(v1[0] - bf_lo(h.z), v1[1] - bf_hi(h.z)); l.w = cvt_pk_bf16(v1[2] - bf_lo(h.w), v1[3] - bf_hi(h.w));
                    *(u32x4*)(HB + o) = h; *(u32x4*)(HL + o) = l;
                }
                ss += __shfl_xor(ss, 16); ss += __shfl_xor(ss, 32);
                if (fq == 0) rowsq[(size_t)row * 16 + u.pn * 4 + wc] = ss;
            }
    }
};

struct EpiGlu {
    static constexpr bool PERM = true, AFTER_DRAIN = false, PERM_A = false;
    bf16_t* O;
    __device__ __forceinline__ void operator()(const f32x4 (&acc)[2][2][4][2], const Unit& u, int wr, int wc, int fr, int fq) const {
        const int col0 = u.pn * HALF + wc * 32 + 8 * fq;
        const int row0 = u.pm * BM + wr * 64 + fr;
#pragma unroll
        for (int ai = 0; ai < 2; ++ai)
#pragma unroll
            for (int m = 0; m < 4; ++m) {
                const int row = row0 + ai * HALF + m * 16;
                f32x4 v0, v1;
#pragma unroll
                for (int e = 0; e < 4; ++e) { v0[e] = acc[ai][0][m][0][e] * fsigmoid(acc[ai][1][m][0][e]); v1[e] = acc[ai][0][m][1][e] * fsigmoid(acc[ai][1][m][1][e]); }
                u32x4 w; w.x = cvt_pk_bf16(v0[0], v0[1]); w.y = cvt_pk_bf16(v0[2], v0[3]); w.z = cvt_pk_bf16(v1[0], v1[1]); w.w = cvt_pk_bf16(v1[2], v1[3]);
                *(u32x4*)(O + (size_t)row * 1024 + col0) = w;
            }
    }
};

struct EpiFfnUp {
    static constexpr bool PERM = true, AFTER_DRAIN = false, PERM_A = true;
    bf16_t* ACT; float* HALO; const float* rowsq; const float* cw; const float* cb; PG8_LAS float* ex; PG8_LAS float* wl;
    __device__ __forceinline__ void operator()(f32x4 (&acc)[2][2][4][2], const Unit& u, int wr, int wc, int fr_, int fq_) const {
        int fr = fr_, fq = fq_; asm volatile("" : "+v"(fr), "+v"(fq));
        const int lane = fr + 16 * fq;
        const int rowt = wr * 64 + 4 * fr, colt = wc * 32 + 8 * fq;
        const int tid = 64 * (4 * wr + wc) + lane, tc = tid & 255, p2 = tid >> 8;
        const int upc = (tc < HALF) ? (u.pn * HALF + tc) : (3072 + u.pn * HALF + (tc - HALF));
        const float wl_a = cw[p2 * 6144 + upc], wl_b = (p2 == 0) ? cw[2 * 6144 + upc] : cb[upc];
#pragma unroll
        for (int ai = 0; ai < 2; ++ai)
#pragma unroll
            for (int m = 0; m < 4; ++m) {
                const float rs = (ex + 3072)[u.idx * 256 + ai * HALF + rowt + m];
#pragma unroll
                for (int bj = 0; bj < 2; ++bj)
#pragma unroll
                    for (int n = 0; n < 2; ++n) acc[ai][bj][m][n] = acc[ai][bj][m][n] * rs;
                asm volatile("" : "+v"(acc[ai][0][m][0]), "+v"(acc[ai][0][m][1]), "+v"(acc[ai][1][m][0]), "+v"(acc[ai][1][m][1]));
            }
        if (fr == 15) {
#pragma unroll
            for (int ai = 0; ai < 2; ++ai)
#pragma unroll
                for (int bj = 0; bj < 2; ++bj)
#pragma unroll
                    for (int n = 0; n < 2; ++n)
#pragma unroll
                        for (int w = 0; w < 2; ++w) {
                            const f32x4 x = acc[ai][bj][2 + w][n];
                            *(PG8_LAS f32x4*)(ex + ((2 * ai + wr) * 2 + w) * 256 + bj * HALF + colt + 4 * n) = x;
                            if (ai == 1 && wr == 1) *(f32x4*)(HALO + ((size_t)(u.pm * 4 + 2 + w)) * 6144 + u.pn * BM + bj * HALF + colt + 4 * n) = x;
                        }
        }
        if (wr == 0 && fr == 0) {
#pragma unroll
            for (int bj = 0; bj < 2; ++bj)
#pragma unroll
                for (int n = 0; n < 2; ++n)
#pragma unroll
                    for (int w = 0; w < 2; ++w)
                        *(f32x4*)(HALO + ((size_t)(u.pm * 4 + w)) * 6144 + u.pn * BM + bj * HALF + colt + 4 * n) = acc[0][bj][w][n];
        }
        wl[p2 * 256 + tc] = wl_a; wl[(p2 + 2) * 256 + tc] = wl_b;
        asm volatile("s_waitcnt lgkmcnt(0)" ::: "memory"); __builtin_amdgcn_s_barrier(); asm volatile("" ::: "memory");
#pragma unroll
        for (int n = 0; n < 2; ++n) {
            const int oc = u.pn * HALF + colt + 4 * n;
            PG8_LAS const float* wp = wl + colt + 4 * n;
            const f32x4 wa0 = *(PG8_LAS const f32x4*)(wp), wa1 = *(PG8_LAS const f32x4*)(wp + 256), wa2 = *(PG8_LAS const f32x4*)(wp + 512), ba = *(PG8_LAS const f32x4*)(wp + 768);
            const f32x4 wg0 = *(PG8_LAS const f32x4*)(wp + HALF), wg1 = *(PG8_LAS const f32x4*)(wp + 256 + HALF), wg2 = *(PG8_LAS const f32x4*)(wp + 512 + HALF), bg = *(PG8_LAS const f32x4*)(wp + 768 + HALF);
#pragma unroll
            for (int ai = 0; ai < 2; ++ai) {
                const int idx = 2 * ai + wr;
                f32x4 h2a = {0.f, 0.f, 0.f, 0.f}, h1a = h2a, h2g = h2a, h1g = h2a;
                if (idx > 0) {
                    const PG8_LAS float* e0 = ex + ((idx - 1) * 2) * 256 + colt + 4 * n;
                    h2a = *(const PG8_LAS f32x4*)(e0); h2g = *(const PG8_LAS f32x4*)(e0 + HALF);
                    h1a = *(const PG8_LAS f32x4*)(e0 + 256); h1g = *(const PG8_LAS f32x4*)(e0 + 256 + HALF);
                }
                f32x4 s2a, s3a, s2g, s3g;
#pragma unroll
                for (int e = 0; e < 4; ++e) {
                    float d2a, d3a, d2g, d3g;
                    asm("v_mov_b32_dpp %0, %1 row_shr:1 row_mask:0xf bank_mask:0xf bound_ctrl:1" : "=v"(d2a) : "v"(acc[ai][0][2][n][e]));
                    asm("v_mov_b32_dpp %0, %1 row_shr:1 row_mask:0xf bank_mask:0xf bound_ctrl:1" : "=v"(d3a) : "v"(acc[ai][0][3][n][e]));
                    asm("v_mov_b32_dpp %0, %1 row_shr:1 row_mask:0xf bank_mask:0xf bound_ctrl:1" : "=v"(d2g) : "v"(acc[ai][1][2][n][e]));
                    asm("v_mov_b32_dpp %0, %1 row_shr:1 row_mask:0xf bank_mask:0xf bound_ctrl:1" : "=v"(d3g) : "v"(acc[ai][1][3][n][e]));
                    s2a[e] = (fr == 0) ? h2a[e] : d2a; s3a[e] = (fr == 0) ? h1a[e] : d3a;
                    s2g[e] = (fr == 0) ? h2g[e] : d2g; s3g[e] = (fr == 0) ? h1g[e] : d3g;
                }
#pragma unroll
                for (int m = 0; m < 4; ++m) {
                    const f32x4 xa = acc[ai][0][m][n], xg = acc[ai][1][m][n];
                    const f32x4 p1a = (m == 0) ? s3a : acc[ai][0][m > 0 ? m - 1 : 0][n], p1g = (m == 0) ? s3g : acc[ai][1][m > 0 ? m - 1 : 0][n];
                    const f32x4 p2a = (m == 0) ? s2a : (m == 1) ? s3a : acc[ai][0][m > 1 ? m - 2 : 0][n], p2g = (m == 0) ? s2g : (m == 1) ? s3g : acc[ai][1][m > 1 ? m - 2 : 0][n];
                    const f32x4 ca = ba + wa2 * xa + wa1 * p1a + wa0 * p2a;
                    const f32x4 cgv = bg + wg2 * xg + wg1 * p1g + wg0 * p2g;
                    const f32x2 o01 = gelu_gate_pk((f32x2){ca[0], ca[1]}, (f32x2){cgv[0], cgv[1]}), o23 = gelu_gate_pk((f32x2){ca[2], ca[3]}, (f32x2){cgv[2], cgv[3]});
                    u32x2 w; w.x = cvt_pk_bf16(o01.x, o01.y); w.y = cvt_pk_bf16(o23.x, o23.y);
                    *(u32x2*)(ACT + (size_t)(u.pm * BM + ai * HALF + rowt + m) * 3072 + oc) = w;
                    __builtin_amdgcn_sched_barrier(0);
                }
            }
        }
    }
};

template <class Epi, class Sched, bool ALIGN_EPI = false, bool SP2 = false>
__device__ __forceinline__ void gemm_phase(PG8_LAS unsigned char* lds, const Gemm g, const Sched& S, const Epi& E) {
    int tid_ = threadIdx.x; asm volatile("" : "+v"(tid_)); const int tid = tid_, wid = __builtin_amdgcn_readfirstlane(tid >> 6), lane = tid & 63, wr = wid >> 2, wc = wid & 3, fr = lane & 15, fq = lane >> 4;
    const int K = g.K, nt = K / BK;
    unsigned voffA[2], voffB[2];
#pragma unroll
    for (int i = 0; i < 2; ++i) { int R, C; stage_rc(tid * 16 + i * 8192, R, C); const int Rb = Epi::PERM ? ((R & ~31) + perm32(R & 31)) : R;
        const int Ra = Epi::PERM_A ? ((R & 64) | (4 * (R & 15) + ((R >> 4) & 3))) : R; voffA[i] = (unsigned)(Ra * K + C) * 2u; voffB[i] = (unsigned)(Rb * K + C) * 2u; }
    const size_t kstep = (size_t)(BK * 2);
    const size_t hstep = (size_t)HALF * K * 2;
    const size_t tstep = 2 * hstep;
    const unsigned ldsw = (unsigned)wid * 1024u;
    const int aoff = lds_byte(wr * 64 + fr, fq * 8), boff = lds_byte(wc * 32 + fr, fq * 8);
#define PG8_SA(b, h) (((b) * 2 + (h)) * HTB)
#define PG8_SB(b, h) ((4 + (b) * 2 + (h)) * HTB)
#define PG8_STAGE(bufoff, gbase, voff) do { _Pragma("unroll") for (int _i = 0; _i < 2; ++_i) \
        __builtin_amdgcn_global_load_lds((const unsigned*)((const char*)(gbase) + (voff)[_i]), (PG8_LAS unsigned*)(lds + (bufoff) + ldsw + _i * 8192), 16, 0, 0); } while (0)
#define PG8_LDA(dst, b, h) do { _Pragma("unroll") for (int m = 0; m < 4; ++m) _Pragma("unroll") for (int k = 0; k < 2; ++k) dst[m][k] = *(const PG8_LAS bf16x8*)(lds + PG8_SA(b, h) + aoff + m * 2048 + k * 1024); } while (0)
#define PG8_LDB(dst, b, h) do { _Pragma("unroll") for (int n = 0; n < 2; ++n) _Pragma("unroll") for (int k = 0; k < 2; ++k) dst[n][k] = *(const PG8_LAS bf16x8*)(lds + PG8_SB(b, h) + boff + n * 2048 + k * 1024); } while (0)
#define PG8_MMA(ai, bj, At, Bt) do { __builtin_amdgcn_s_setprio(1); _Pragma("unroll") for (int m = 0; m < 4; ++m) _Pragma("unroll") for (int n = 0; n < 2; ++n) _Pragma("unroll") for (int k = 0; k < 2; ++k) \
        acc[ai][bj][m][n] = __builtin_amdgcn_mfma_f32_16x16x32_bf16(Bt[n][k], At[m][k], acc[ai][bj][m][n], 0, 0, 0); __builtin_amdgcn_s_setprio(0); } while (0)
#define PG8_WAIT_V(n) asm volatile("s_waitcnt vmcnt(" #n ")" ::: "memory")
#define PG8_WAIT_L(n) asm volatile("s_waitcnt lgkmcnt(" #n ")" ::: "memory")
#define PG8_BAR __builtin_amdgcn_s_barrier()
#define PG8_SCHED __builtin_amdgcn_sched_barrier(0)
    Unit cur, nxt; int ui = 0;
    if (!S.next(0, cur)) return;
    f32x4 acc[2][2][4][2];
#pragma unroll
    for (int a = 0; a < 2; ++a)
#pragma unroll
        for (int b = 0; b < 2; ++b)
#pragma unroll
            for (int m = 0; m < 4; ++m)
#pragma unroll
                for (int n = 0; n < 2; ++n) acc[a][b][m][n] = (f32x4){0.f, 0.f, 0.f, 0.f};
    bf16x8 At[4][2], B0[2][2], B1[2][2];
    const char* cA = (const char*)g.A + (size_t)cur.pm * tstep; const char* cB = (const char*)g.Bt + (size_t)cur.pn * tstep;
    S.a_ready(cur);
    if constexpr (SP2) {
        PG8_STAGE(PG8_SB(0, 0), cB, voffB); PG8_STAGE(PG8_SB(0, 1), cB + hstep, voffB); PG8_STAGE(PG8_SA(0, 0), cA, voffA); PG8_STAGE(PG8_SA(0, 1), cA + hstep, voffA);
        if (wr == 1) PG8_BAR;
        PG8_WAIT_V(2); PG8_BAR;
        PG8_STAGE(PG8_SB(1, 0), cB + kstep, voffB); PG8_STAGE(PG8_SA(1, 0), cA + kstep, voffA); PG8_STAGE(PG8_SB(1, 1), cB + hstep + kstep, voffB);
        PG8_WAIT_V(6); PG8_BAR;
    } else {
        PG8_STAGE(PG8_SB(0, 0), cB, voffB); PG8_STAGE(PG8_SA(0, 0), cA, voffA); PG8_STAGE(PG8_SB(0, 1), cB + hstep, voffB); PG8_STAGE(PG8_SA(0, 1), cA + hstep, voffA);
        if (wr == 1) PG8_BAR;
        PG8_WAIT_V(4); PG8_BAR;
        PG8_STAGE(PG8_SB(1, 0), cB + kstep, voffB); PG8_STAGE(PG8_SA(1, 0), cA + kstep, voffA); PG8_STAGE(PG8_SB(1, 1), cB + hstep + kstep, voffB);
        PG8_WAIT_V(6); PG8_BAR;
    }
    for (;;) {
        const bool has_next = S.next(ui + 1, nxt);
        const char* nA = has_next ? (const char*)g.A + (size_t)nxt.pm * tstep : cA; const char* nB = has_next ? (const char*)g.Bt + (size_t)nxt.pn * tstep : cB;
        for (int t = 0; t < nt; t += 2) {
            const bool last = (t == nt - 2);
            const char* a1 = cA + (size_t)(t + 1) * kstep;
            const char* a2 = last ? nA : cA + (size_t)(t + 2) * kstep; const char* b2 = last ? nB : cB + (size_t)(t + 2) * kstep;
            const char* a3 = a2 + kstep; const char* b3 = b2 + kstep;
            if (last && has_next) S.a_ready(nxt);
            if constexpr (SP2) {
            PG8_LDB(B0, 0, 0); PG8_LDB(B1, 0, 1); PG8_SCHED; PG8_LDA(At, 0, 0); PG8_STAGE(PG8_SA(1, 1), a1 + hstep, voffA);
            PG8_WAIT_V(8); PG8_WAIT_L(0); PG8_BAR; PG8_MMA(0, 0, At, B0); PG8_MMA(0, 1, At, B1); PG8_BAR; PG8_SCHED;
            PG8_LDA(At, 0, 1); PG8_STAGE(PG8_SB(0, 0), b2, voffB); PG8_STAGE(PG8_SB(0, 1), b2 + hstep, voffB); PG8_STAGE(PG8_SA(0, 0), a2, voffA);
            PG8_WAIT_V(8); PG8_WAIT_L(0); PG8_BAR; PG8_MMA(1, 0, At, B0); PG8_MMA(1, 1, At, B1); PG8_BAR; PG8_SCHED;
            PG8_LDB(B0, 1, 0); PG8_LDB(B1, 1, 1); PG8_SCHED; PG8_LDA(At, 1, 0); PG8_STAGE(PG8_SA(0, 1), a2 + hstep, voffA);
            PG8_WAIT_V(8); PG8_WAIT_L(0); PG8_BAR; PG8_MMA(0, 0, At, B0); PG8_MMA(0, 1, At, B1); PG8_BAR; PG8_SCHED;
            PG8_LDA(At, 1, 1); PG8_STAGE(PG8_SB(1, 0), b3, voffB); PG8_STAGE(PG8_SB(1, 1), b3 + hstep, voffB); PG8_STAGE(PG8_SA(1, 0), a3, voffA);
            PG8_WAIT_V(8); PG8_WAIT_L(0); PG8_BAR; PG8_MMA(1, 0, At, B0); PG8_MMA(1, 1, At, B1); PG8_BAR; PG8_SCHED;
            } else {
            PG8_LDB(B0, 0, 0); PG8_SCHED; PG8_LDA(At, 0, 0); PG8_STAGE(PG8_SA(1, 1), a1 + hstep, voffA);
            PG8_WAIT_L(8); PG8_BAR; PG8_WAIT_L(0); PG8_MMA(0, 0, At, B0); PG8_BAR; PG8_SCHED;
            PG8_LDB(B1, 0, 1); PG8_STAGE(PG8_SB(0, 0), b2, voffB);
            PG8_BAR; PG8_WAIT_L(0); PG8_MMA(0, 1, At, B1); PG8_BAR;
            PG8_LDA(At, 0, 1); PG8_STAGE(PG8_SA(0, 0), a2, voffA);
            PG8_BAR; PG8_WAIT_L(0); PG8_MMA(1, 0, At, B0); PG8_BAR; PG8_SCHED;
            PG8_STAGE(PG8_SB(0, 1), b2 + hstep, voffB);
            PG8_WAIT_V(6); PG8_BAR; PG8_MMA(1, 1, At, B1); PG8_BAR;
            PG8_LDB(B0, 1, 0); PG8_SCHED; PG8_LDA(At, 1, 0); PG8_STAGE(PG8_SA(0, 1), a2 + hstep, voffA);
            PG8_WAIT_L(8); PG8_BAR; PG8_WAIT_L(0); PG8_MMA(0, 0, At, B0); PG8_BAR; PG8_SCHED;
            PG8_LDB(B1, 1, 1); PG8_STAGE(PG8_SB(1, 0), b3, voffB);
            PG8_BAR; PG8_WAIT_L(0); PG8_MMA(0, 1, At, B1); PG8_BAR;
            PG8_LDA(At, 1, 1); PG8_STAGE(PG8_SA(1, 0), a3, voffA);
            PG8_BAR; PG8_WAIT_L(0); PG8_MMA(1, 0, At, B0); PG8_BAR; PG8_SCHED;
            PG8_STAGE(PG8_SB(1, 1), b3 + hstep, voffB);
            PG8_WAIT_V(6); PG8_BAR; PG8_MMA(1, 1, At, B1); PG8_BAR;
            }
        }
        if constexpr (ALIGN_EPI) { if (wr == 0) PG8_BAR; }
        if constexpr (!Epi::AFTER_DRAIN) { E(acc, cur, wr, wc, fr, fq); S.done(cur); }
        if (!has_next) break;
#pragma unroll
        for (int a = 0; a < 2; ++a)
#pragma unroll
            for (int b = 0; b < 2; ++b)
#pragma unroll
                for (int m = 0; m < 4; ++m)
#pragma unroll
                    for (int n = 0; n < 2; ++n) acc[a][b][m][n] = (f32x4){0.f, 0.f, 0.f, 0.f};
        cur = nxt; cA = nA; cB = nB; ++ui;
        if constexpr (ALIGN_EPI) { if (wr == 1) PG8_BAR; }
    }
    PG8_WAIT_V(0);
    if constexpr (!ALIGN_EPI) { if (wr == 0) PG8_BAR; }
    PG8_BAR;
    if constexpr (Epi::AFTER_DRAIN) { E.fused(acc, cur, wr, wc, fr, fq, lds, wid, lane); S.done(cur); }
#undef PG8_SA
#undef PG8_SB
#undef PG8_STAGE
#undef PG8_LDA
#undef PG8_LDB
#undef PG8_MMA
#undef PG8_WAIT_V
#undef PG8_WAIT_L
#undef PG8_BAR
#undef PG8_SCHED
}
}

#define LAS __attribute__((address_space(3)))
typedef unsigned short bf16;
typedef pg8::f32x4 f32x4;
typedef pg8::u32x4 u32x4;
typedef pg8::u32x2 u32x2;
typedef pg8::bf16x8 bf16x8;
typedef short s16x4 __attribute__((ext_vector_type(4)));
typedef float f32x2 __attribute__((ext_vector_type(2)));
using pg8::cvt_pk_bf16; using pg8::fsigmoid; using pg8::gelu_t; using pg8::bf_lo; using pg8::bf_hi;

constexpr int T = 32768, D = 1024, SEQ = 8192, NWAVES = 8;
constexpr int LDS_BYTES = 163840;
constexpr size_t MiB = 1u << 20;
constexpr size_t WS_CTL = 0, CTL_ZERO_BYTES = 65536;
constexpr size_t WS_ABAR = 1 * MiB;
constexpr size_t WS_BBAR = 1 * MiB + 256 * 1024;
constexpr size_t WS_CMAT = 2 * MiB;
constexpr size_t WS_GATES = 3 * MiB;
constexpr size_t WS_SUMM = 4 * MiB;
constexpr size_t WS_ROWSQ = 6 * MiB;
constexpr size_t WS_RG_WIN = 8 * MiB;
constexpr size_t WS_RG_WOUT = 16 * MiB;
constexpr size_t WS_S5_WIN = 20 * MiB;
constexpr size_t WS_S5_WGLU = 24 * MiB;
constexpr size_t WS_S5_WOUT = 32 * MiB;
constexpr size_t WS_FFN_WUP = 36 * MiB;
constexpr size_t WS_FFN_WDN = 84 * MiB;
constexpr size_t WS_HALO = 108 * MiB;
constexpr size_t WS_HB = 120 * MiB;
constexpr size_t WS_BIG = 184 * MiB;
constexpr size_t WS_HL = 376 * MiB;
constexpr size_t WS_END = 440 * MiB;

struct Args { const float* in[28]; float* out; unsigned char* ws; };

__device__ __forceinline__ float wave_sum(float v) {
#pragma unroll
    for (int o = 1; o < 64; o <<= 1) v += __shfl_xor(v, o);
    return v;
}
__device__ __forceinline__ unsigned f2bf(float f) { unsigned u = __builtin_bit_cast(unsigned, f); return (u + 0x7fffu + ((u >> 16) & 1u)) >> 16; }
__device__ __forceinline__ unsigned pk2(float lo, float hi) { return f2bf(lo) | (f2bf(hi) << 16); }
#define LDS_WAIT() asm volatile("s_waitcnt lgkmcnt(0)" ::: "memory")

#define XB_TMO      128
#define XB_XCNT(j)  (256  + 64 * (j))
#define XB_XSUB(j)  (1280 + 64 * (j))
#define XB_XGEN(j)  (2304 + 64 * (j))
#define XB_TOP      3328
#define XB_TOPGEN   3392
#define XCD_BAR_WORDS 3456
#define XB_SPIN_CAP (1u << 18)

__device__ __forceinline__ unsigned xb_ld(unsigned* p)              { return __hip_atomic_load(p, __ATOMIC_RELAXED, __HIP_MEMORY_SCOPE_AGENT); }
__device__ __forceinline__ unsigned xb_add(unsigned* p, unsigned v) { return __hip_atomic_fetch_add(p, v, __ATOMIC_RELAXED, __HIP_MEMORY_SCOPE_AGENT); }
__device__ __forceinline__ unsigned xb_xcc_id() { return (unsigned)__builtin_amdgcn_s_getreg((3 << 11) | 20) & 0xFu; }
#define XB_SPIN(cond, bar) do { unsigned _sp = 0; while (cond) { __builtin_amdgcn_s_sleep(1); \
    if ((++_sp & 255u) == 0u) { if (xb_ld(&(bar)[XB_TMO])) break; if (_sp > XB_SPIN_CAP) { atomicAdd(&(bar)[XB_TMO], 1u); break; } } } } while (0)

struct XcdBarrier {
    unsigned* bar; unsigned x;
    volatile LAS unsigned* st;
};

__device__ __forceinline__ XcdBarrier xcd_barrier_post(unsigned* bar, volatile LAS unsigned* st) {
    XcdBarrier b; b.bar = bar; b.x = xb_xcc_id(); b.st = st;
    if (threadIdx.x == 0) (void)xb_add(&bar[XB_XCNT(b.x)], 1u);
    return b;
}
__device__ __forceinline__ void xcd_barrier_complete(unsigned* bar, unsigned x, unsigned& nloc, unsigned& nx) {
    const unsigned G = gridDim.x * gridDim.y * gridDim.z;
    unsigned sum, cnt, mine, sp = 0u;
    for (;;) {
        sum = 0u; cnt = 0u; mine = 0u;
#pragma unroll
        for (unsigned j = 0; j < 16; ++j) { const unsigned c = xb_ld(&bar[XB_XCNT(j)]); sum += c; cnt += (c > 0u) ? 1u : 0u; mine = (j == x) ? c : mine; }
        if (sum == G) break;
        __builtin_amdgcn_s_sleep(1);
        if ((++sp & 255u) == 0u) { if (xb_ld(&bar[XB_TMO])) break; if (sp > XB_SPIN_CAP) { atomicAdd(&bar[XB_TMO], 1u); break; } }
    }
    nloc = mine > 0u ? mine : 1u; nx = cnt > 0u ? cnt : 1u;
}

__device__ __forceinline__ void xcd_barrier(const XcdBarrier& b) {
    asm volatile("s_waitcnt vmcnt(0)" ::: "memory");
    __syncthreads();
    if (threadIdx.x == 0) {
        unsigned* bar = b.bar;
        __builtin_amdgcn_s_waitcnt(0);
        unsigned nloc = b.st[0], nx = b.st[1];
        if (nloc == 0u) { xcd_barrier_complete(bar, b.x, nloc, nx); b.st[0] = nloc; b.st[1] = nx; }
        const unsigned old = xb_add(&bar[XB_XSUB(b.x)], 1u);
        const unsigned gen = old / nloc;
        if (old + 1u == (gen + 1u) * nloc) {
            __builtin_amdgcn_fence(__ATOMIC_RELEASE, "agent");
            asm volatile("s_waitcnt vmcnt(0)" ::: "memory");
            const unsigned og = xb_add(&bar[XB_TOP], 1u);
            const unsigned tg = og / nx;
            if (og + 1u == (tg + 1u) * nx) xb_add(&bar[XB_TOPGEN], 1u);
            else XB_SPIN(xb_ld(&bar[XB_TOPGEN]) == tg, bar);
            __builtin_amdgcn_fence(__ATOMIC_ACQUIRE, "agent");
            xb_add(&bar[XB_XGEN(b.x)], 1u);
            asm volatile("s_waitcnt vmcnt(0)" ::: "memory");
        } else {
            XB_SPIN(xb_ld(&bar[XB_XGEN(b.x)]) == gen, bar);
            __builtin_amdgcn_fence(__ATOMIC_ACQUIRE, "agent");
            asm volatile("s_waitcnt vmcnt(0)" ::: "memory");
        }
    }
    __syncthreads();
}

__device__ __forceinline__ void transpose_item(const float* W, int K, int N, bf16* WT, const float* gain, int pair_half, LAS float* scr, int item, int lane, float scale = 1.0f) {
    const int nblk = N / 32, kb = item / nblk, nb = item % nblk, k0 = 64 * kb, n0 = 32 * nb;
    float wv[32];
#pragma unroll
    for (int i = 0; i < 32; ++i) wv[i] = W[(size_t)(k0 + 2 * i + (lane >> 5)) * N + n0 + (lane & 31)];
    if (gain) {
#pragma unroll
        for (int i = 0; i < 32; ++i) wv[i] *= gain[k0 + 2 * i + (lane >> 5)];
    }
    if (scale != 1.0f) {
#pragma unroll
        for (int i = 0; i < 32; ++i) wv[i] *= scale;
    }
#pragma unroll
    for (int i = 0; i < 32; ++i) scr[(2 * i + (lane >> 5)) * 33 + (lane & 31)] = wv[i];
    LDS_WAIT(); asm volatile("" ::: "memory");
    int dn0 = n0;
    if (pair_half) dn0 = (n0 < pair_half) ? (256 * (n0 / 128) + (n0 % 128)) : (256 * ((n0 - pair_half) / 128) + 128 + ((n0 - pair_half) % 128));
    const int c = lane & 7;
#pragma unroll
    for (int j = 0; j < 4; ++j) {
        const int n = (lane >> 3) + 8 * j; const LAS float* s = scr + (8 * c) * 33 + n;
        u32x4 o; o.x = pk2(s[0 * 33], s[1 * 33]); o.y = pk2(s[2 * 33], s[3 * 33]); o.z = pk2(s[4 * 33], s[5 * 33]); o.w = pk2(s[6 * 33], s[7 * 33]);
        *(u32x4*)(WT + (size_t)(dn0 + n) * K + k0 + 8 * c) = o;
    }
    LDS_WAIT(); asm volatile("" ::: "memory");
}

__device__ __forceinline__ void prologue(LAS unsigned char* lds, const Args& a) {
    int tid_ = threadIdx.x; asm volatile("" : "+v"(tid_));
    const int tid = tid_, lane = tid & 63, wave = tid >> 6;
    unsigned char* ws = a.ws;
    LAS float* scr = (LAS float*)(lds + wave * 16384);
    const int gw = blockIdx.x * NWAVES + wave, NGW = gridDim.x * NWAVES;
    constexpr int I_UP = 16 * 192, I_DN = 48 * 32, I_2K = 16 * 64, I_1K = 16 * 32, I_G = 2 * 4;
    constexpr int S0 = 4 * I_UP, S1 = S0 + 4 * I_DN, S2 = S1 + 2 * I_2K, S3 = S2 + 2 * I_2K, S4 = S3 + 2 * I_1K, S5 = S4 + 2 * I_1K, S6 = S5 + 2 * I_1K, S7 = S6 + 32 * I_G;
    for (int it = gw; it < S7; it += NGW) {
        if (it < S0) { const int i = it / I_UP, r = it % I_UP;
            transpose_item(a.in[24] + (size_t)i * 1024 * 6144, 1024, 6144, (bf16*)(ws + WS_FFN_WUP) + (size_t)i * 6144 * 1024, a.in[2] + i * 1024, 3072, scr, r, lane); }
        else if (it < S1) { const int i = (it - S0) / I_DN, r = (it - S0) % I_DN;
            transpose_item(a.in[27] + (size_t)i * 3072 * 1024, 3072, 1024, (bf16*)(ws + WS_FFN_WDN) + (size_t)i * 1024 * 3072, nullptr, 0, scr, r, lane); }
        else if (it < S2) { const int j = (it - S1) / I_2K, r = (it - S1) % I_2K;
            transpose_item(a.in[4] + (size_t)j * 1024 * 2048, 1024, 2048, (bf16*)(ws + WS_RG_WIN) + (size_t)j * 2048 * 1024, a.in[1] + (2 * j) * 1024, 0, scr, r, lane); }
        else if (it < S3) { const int j = (it - S2) / I_2K, r = (it - S2) % I_2K;
            transpose_item(a.in[22] + (size_t)j * 1024 * 2048, 1024, 2048, (bf16*)(ws + WS_S5_WGLU) + (size_t)j * 2048 * 1024, nullptr, 1024, scr, r, lane); }
        else if (it < S4) { const int j = (it - S3) / I_1K, r = (it - S3) % I_1K;
            transpose_item(a.in[12] + (size_t)j * 1024 * 1024, 1024, 1024, (bf16*)(ws + WS_RG_WOUT) + (size_t)j * 1024 * 1024, nullptr, 0, scr, r, lane); }
        else if (it < S5) { const int j = (it - S4) / I_1K, r = (it - S4) % I_1K;
            transpose_item(a.in[13] + (size_t)j * 1024 * 1024, 1024, 1024, (bf16*)(ws + WS_S5_WIN) + (size_t)j * 1024 * 1024, a.in[1] + (2 * j + 1) * 1024, 0, scr, r, lane); }
        else if (it < S6) { const int j = (it - S5) / I_1K, r = (it - S5) % I_1K;
            transpose_item(a.in[23] + (size_t)j * 1024 * 1024, 1024, 1024, (bf16*)(ws + WS_S5_WOUT) + (size_t)j * 1024 * 1024, nullptr, 0, scr, r, lane); }
        else { const int mtx = (it - S6) / I_G, r = (it - S6) % I_G;
            const int layer = mtx >> 4, gate = (mtx >> 3) & 1, head = mtx & 7;
            const float* src = (gate ? a.in[9] : a.in[7]) + ((size_t)layer * 8 + head) * 128 * 128;
            transpose_item(src, 128, 128, (bf16*)(ws + WS_GATES) + (size_t)mtx * 128 * 128, nullptr, 0, scr, r, lane, -1.4426950408889634f); }
    }
    for (int e = blockIdx.x * 512 + tid; e < 2 * 64 * 64; e += gridDim.x * 512) {
        const int p = e & 63, jg = e >> 6;
        const float ar = a.in[14][e], ai = a.in[15][e], dt = expf(a.in[16][jg]);
        const float mag = expf(ar * dt), ang = ai * dt;
        const float abr = mag * cosf(ang), abi = mag * sinf(ang);
        float* AB = (float*)(ws + WS_ABAR); AB[2 * e] = abr; AB[2 * e + 1] = abi;
        const float ur = abr - 1.0f, ui = abi, den = ar * ar + ai * ai;
        const float wr_ = (ur * ar + ui * ai) / den, wi_ = (ui * ar - ur * ai) / den;
        bf16* BB = (bf16*)(ws + WS_BBAR) + (size_t)jg * 128 * 16;
        const float* bre = a.in[17] + (size_t)e * 16; const float* bim = a.in[18] + (size_t)e * 16;
#pragma unroll
        for (int c = 0; c < 16; ++c) {
            const float br = bre[c], bi = bim[c];
            BB[p * 16 + c] = (bf16)f2bf(wr_ * br - wi_ * bi);
            BB[(64 + p) * 16 + c] = (bf16)f2bf(wr_ * bi + wi_ * br);
        }
        bf16* CM = (bf16*)(ws + WS_CMAT) + (size_t)jg * 16 * 128;
        const int kq = 8 * (p & 15) + (p >> 4);
#pragma unroll
        for (int c = 0; c < 16; ++c) {
            CM[c * 128 + kq] = (bf16)f2bf(a.in[19][((size_t)jg * 16 + c) * 64 + p]);
            CM[c * 128 + kq + 4] = (bf16)f2bf(-a.in[20][((size_t)jg * 16 + c) * 64 + p]);
        }
    }
    {
        const float* x = a.in[0]; bf16* HB = (bf16*)(ws + WS_HB); float* rowsq = (float*)(ws + WS_ROWSQ);
        for (int m0 = gw; m0 < T; m0 += 4 * NGW) {
            f32x4 v[4][4];
#pragma unroll
            for (int q = 0; q < 4; ++q) { const int m = m0 + q * NGW; const f32x4* xr = (const f32x4*)(x + (size_t)(m < T ? m : m0) * D) + lane;
#pragma unroll
                for (int j = 0; j < 4; ++j) v[q][j] = xr[64 * j]; }
#pragma unroll
            for (int q = 0; q < 4; ++q) {
                const int m = m0 + q * NGW; if (m >= T) continue;
                float s = 0.f;
#pragma unroll
                for (int j = 0; j < 4; ++j) s += (v[q][j][0] * v[q][j][0] + v[q][j][1] * v[q][j][1]) + (v[q][j][2] * v[q][j][2] + v[q][j][3] * v[q][j][3]);
                s = wave_sum(s);
                u32x2* o8 = (u32x2*)(HB + (size_t)m * D) + lane;
#pragma unroll
                for (int j = 0; j < 4; ++j) { u32x2 w; w.x = cvt_pk_bf16(v[q][j][0], v[q][j][1]); w.y = cvt_pk_bf16(v[q][j][2], v[q][j][3]); o8[64 * j] = w; }
                if (lane < 16) rowsq[(size_t)m * 16 + lane] = (lane == 0) ? s : 0.f;
            }
        }
    }
}

struct RgP { const bf16* XR; const bf16* GG; bf16* Y; float* SUMM; const bf16* WA; const bf16* WX; const float* ba; const float* bx; const float* lam; const float* cw; const float* cb; };
constexpr int RG_STRIDE = 528, RG_TILE = 64 * RG_STRIDE, RG_XS = 0, RG_GY = 2 * RG_TILE;

template <int PASS>
__device__ __forceinline__ void rg_issue(const RgP& P, size_t growb, int t0, int chl, u32x4 (&xraw)[7], u32x4 (&ggraw)[4]) {
#pragma unroll
    for (int d = 0; d < 7; ++d) {
        const int tt = t0 - 3 + d;
        const u32x4 raw = *(const u32x4*)(P.XR + (growb + (tt < 0 ? 0 : tt)) * 1024 + chl);
        xraw[d] = (tt < 0) ? (u32x4){0u, 0u, 0u, 0u} : raw;
    }
    if (PASS == 1) {
#pragma unroll
        for (int r = 0; r < 4; ++r) ggraw[r] = *(const u32x4*)(P.GG + (growb + t0 + r) * 1024 + chl);
    }
}
template <int PASS>
__device__ __forceinline__ void rg_commit(LAS unsigned char* lds, const RgP& P, int buf, int rho0, int cc, int chl_, const u32x4 (&xraw)[7], const u32x4 (&ggraw)[4]) {
    int chl = chl_; asm volatile("" : "+v"(chl));
    f32x4 cwv[4][2], cbv[2];
#pragma unroll
    for (int d = 0; d < 4; ++d) { cwv[d][0] = *(const f32x4*)(P.cw + d * 1024 + chl); cwv[d][1] = *(const f32x4*)(P.cw + d * 1024 + chl + 4); }
    cbv[0] = *(const f32x4*)(P.cb + chl); cbv[1] = *(const f32x4*)(P.cb + chl + 4);
#pragma unroll
    for (int r = 0; r < 4; ++r) {
        f32x4 o0 = cbv[0], o1 = cbv[1];
#pragma unroll
        for (int d = 0; d < 4; ++d) {
            const u32x4 raw = xraw[r + d];
            const f32x4 x0 = {bf_lo(raw.x), bf_hi(raw.x), bf_lo(raw.y), bf_hi(raw.y)}, x1 = {bf_lo(raw.z), bf_hi(raw.z), bf_lo(raw.w), bf_hi(raw.w)};
            o0 += cwv[d][0] * x0; o1 += cwv[d][1] * x1;
        }
        u32x4 w; w.x = cvt_pk_bf16(o0[0], o0[1]); w.y = cvt_pk_bf16(o0[2], o0[3]); w.z = cvt_pk_bf16(o1[0], o1[1]); w.w = cvt_pk_bf16(o1[2], o1[3]);
        *(LAS u32x4*)(lds + RG_XS + buf * RG_TILE + (rho0 + r) * RG_STRIDE + cc * 16) = w;
        if (PASS == 1) *(LAS u32x4*)(lds + RG_GY + buf * RG_TILE + (rho0 + r) * RG_STRIDE + cc * 16) = ggraw[r];
    }
}

template <int PASS>
__device__ __forceinline__ void rg_mixer(LAS unsigned char* lds, const RgP& P) {
    int tid_ = threadIdx.x; asm volatile("" : "+v"(tid_));
    const int tid = tid_, lane = tid & 63, wave = tid >> 6, fr = lane & 15, fq = lane >> 4;
    const int hl = wave >> 2, slice = wave & 3;
    for (int unit = blockIdx.x; unit < 256; unit += gridDim.x) {
        const int b = unit >> 6, sc = (unit >> 2) & 15, cgp = unit & 3;
        const int chw = 256 * cgp + 128 * hl + 32 * slice, head = 2 * cgp + hl;
        const int colw = 128 * hl + 32 * slice + fr;
        bf16x8 bA[2][4], bX[2][4];
#pragma unroll
        for (int nt = 0; nt < 2; ++nt)
#pragma unroll
            for (int ks = 0; ks < 4; ++ks) {
                const size_t o = ((size_t)head * 128 + 32 * slice + 16 * nt + fr) * 128 + 32 * ks + 8 * fq;
                bA[nt][ks] = *(const bf16x8*)(P.WA + o); bX[nt][ks] = *(const bf16x8*)(P.WX + o);
            }
        float gba[2], gbx[2], sp[2], hc[2], pc[2];
#pragma unroll
        for (int nt = 0; nt < 2; ++nt) {
            const int ch = chw + 16 * nt + fr;
            gba[nt] = -1.4426950408889634f * P.ba[ch]; gbx[nt] = -1.4426950408889634f * P.bx[ch];
            sp[nt] = 8.0f * 1.4426950408889634f * log1pf(expf(-P.lam[ch]));
            hc[nt] = 0.f; pc[nt] = 1.f;
        }
        if (PASS == 1) {
            const int ns = 4 * sc + 3;
            LAS f32x2* SL = (LAS f32x2*)lds;
            for (int e = tid; e < ns * 256; e += 512) { const int s_ = e >> 8, c = e & 255; SL[e] = *(const f32x2*)(P.SUMM + (((size_t)b * 64 + s_) * 1024 + 256 * cgp + c) * 2); }
            __syncthreads();
            const int sub = 4 * sc + fq;
            for (int s_ = 0; s_ < ns; ++s_) {
                if (s_ < sub) {
#pragma unroll
                    for (int nt = 0; nt < 2; ++nt) { const f32x2 v = SL[s_ * 256 + colw + 16 * nt]; hc[nt] = v[0] * hc[nt] + v[1]; }
                }
            }
            __syncthreads();
        }
        const int cc = tid & 31, li = tid >> 5;
        const int chl = 256 * cgp + 8 * cc;
        const int rho0 = 16 * (li & 3) + 4 * (li >> 2);
        const int tq0 = 512 * sc + 128 * (li >> 2) + 4 * (li & 3);
        const size_t growb = (size_t)b * SEQ;
        u32x4 xraw[7], ggraw[4];
        if (PASS == 1) {
            rg_issue<PASS>(P, growb, tq0, chl, xraw, ggraw);
            rg_commit<PASS>(lds, P, 0, rho0, cc, chl, xraw, ggraw);
            __syncthreads();
        }
#pragma unroll 1
        for (int step = 0; step < 8; ++step) {
            const int buf = step & 1;
            if (PASS == 0) {
                rg_issue<PASS>(P, growb, tq0 + 16 * step, chl, xraw, ggraw);
                rg_commit<PASS>(lds, P, buf, rho0, cc, chl, xraw, ggraw);
                __syncthreads();
            }
            if (PASS == 1 && step < 7) rg_issue<PASS>(P, growb, tq0 + 16 * (step + 1), chl, xraw, ggraw);
            if (PASS == 1 && step > 0) {
#pragma unroll
                for (int r = 0; r < 4; ++r)
                    *(u32x4*)(P.Y + (growb + tq0 + 16 * (step - 1) + r) * 1024 + chl) = *(const LAS u32x4*)(lds + RG_GY + (buf ^ 1) * RG_TILE + (rho0 + r) * RG_STRIDE + cc * 16);
            }
            const LAS unsigned char* xs = lds + RG_XS + buf * RG_TILE;
            LAS unsigned char* gy = lds + RG_GY + buf * RG_TILE;
#pragma unroll
            for (int mt = 0; mt < 4; ++mt) {
                bf16x8 af[4];
#pragma unroll
                for (int ks = 0; ks < 4; ++ks) af[ks] = *(const LAS bf16x8*)(xs + (16 * mt + fr) * RG_STRIDE + (128 * hl + 32 * ks + 8 * fq) * 2);
                f32x4 accA[2], accX[2];
#pragma unroll
                for (int nt = 0; nt < 2; ++nt) { accA[nt] = (f32x4){gba[nt], gba[nt], gba[nt], gba[nt]}; accX[nt] = (f32x4){gbx[nt], gbx[nt], gbx[nt], gbx[nt]}; }
#pragma unroll
                for (int ks = 0; ks < 4; ++ks)
#pragma unroll
                    for (int nt = 0; nt < 2; ++nt) {
                        accA[nt] = __builtin_amdgcn_mfma_f32_16x16x32_bf16(af[ks], bA[nt][ks], accA[nt], 0, 0, 0);
                        accX[nt] = __builtin_amdgcn_mfma_f32_16x16x32_bf16(af[ks], bX[nt][ks], accX[nt], 0, 0, 0);
                    }
#pragma unroll
                for (int nt = 0; nt < 2; ++nt)
#pragma unroll
                    for (int r = 0; r < 4; ++r) {
                        const int rho = 16 * mt + 4 * fq + r, col = colw + 16 * nt;
                        const float xr = __builtin_bit_cast(float, (unsigned)(*(const LAS unsigned short*)(xs + rho * RG_STRIDE + col * 2)) << 16);
                        const float rg = __builtin_amdgcn_rcpf(1.0f + __builtin_amdgcn_exp2f(accA[nt][r])), ig = __builtin_amdgcn_rcpf(1.0f + __builtin_amdgcn_exp2f(accX[nt][r]));
                        const float av = __builtin_amdgcn_exp2f(-sp[nt] * rg);
                        const float mult = __builtin_amdgcn_sqrtf(fmaxf(1.0f - av * av, 0.f));
                        hc[nt] = av * hc[nt] + mult * (ig * xr);
                        if (PASS == 0) pc[nt] *= av;
                        if (PASS == 1) {
                            LAS unsigned short* gp = (LAS unsigned short*)(gy + rho * RG_STRIDE + col * 2);
                            const float gyv = __builtin_bit_cast(float, (unsigned)(*gp) << 16);
                            *gp = (unsigned short)f2bf(hc[nt] * gyv);
                        }
                    }
                __builtin_amdgcn_sched_barrier(0);
            }
            if (PASS == 1) { if (step < 7) rg_commit<PASS>(lds, P, buf ^ 1, rho0, cc, chl, xraw, ggraw); __syncthreads(); }
        }
        if (PASS == 1) {
#pragma unroll
            for (int r = 0; r < 4; ++r)
                *(u32x4*)(P.Y + (growb + tq0 + 16 * 7 + r) * 1024 + chl) = *(const LAS u32x4*)(lds + RG_GY + 1 * RG_TILE + (rho0 + r) * RG_STRIDE + cc * 16);
        }
        if (PASS == 0) {
            const int sub = 4 * sc + fq;
#pragma unroll
            for (int nt = 0; nt < 2; ++nt) { f32x2 v; v[0] = pc[nt]; v[1] = hc[nt]; *(f32x2*)(P.SUMM + (((size_t)b * 64 + sub) * 1024 + chw + 16 * nt + fr) * 2) = v; }
        }
        __syncthreads();
    }
}


__device__ __forceinline__ float fma_s(float a, float b, float c) { float r; asm("v_fma_f32 %0, %1, %2, %3" : "=v"(r) : "v"(a), "v"(b), "v"(c)); return r; }
__device__ __forceinline__ float fnma_s(float a, float b, float c) { float r; asm("v_fma_f32 %0, -%1, %2, %3" : "=v"(r) : "v"(a), "v"(b), "v"(c)); return r; }
#define MFMA_TO_ASM_FENCE() do { __builtin_amdgcn_sched_barrier(0); asm volatile("s_nop 15\n\ts_nop 3" ::: "memory"); __builtin_amdgcn_sched_barrier(0); } while (0)
struct S5P { const bf16* U; bf16* G; const float* ABAR; const bf16* BBAR; const bf16* CMAT; const float* dskip; };
constexpr int S5_PF = 8;
constexpr int S5_HS_STRIDE = 272, S5_HS_WAVE = 16 * 272, S5_EST = 36864;

__device__ __forceinline__ void s5_mixer(LAS unsigned char* lds, const S5P& P) {
    int tid_ = threadIdx.x; asm volatile("" : "+v"(tid_));
    const int tid = tid_, lane = tid & 63, wave = tid >> 6, fr = lane & 15, fq = lane >> 4;
    LAS unsigned char* HS = lds + wave * S5_HS_WAVE;
    LAS float* EST = (LAS float*)(lds + S5_EST);
    const f32x4 zero4 = {0.f, 0.f, 0.f, 0.f};
    for (int unit = blockIdx.x; unit < 256; unit += gridDim.x) {
        const int b = unit >> 6, g = unit & 63;
        s16x4 bfr[8];
#pragma unroll
        for (int st = 0; st < 8; ++st) bfr[st] = *(const s16x4*)(P.BBAR + ((size_t)g * 128 + 16 * st + fr) * 16 + 4 * fq);
        bf16x8 cfr[4];
#pragma unroll
        for (int ks = 0; ks < 4; ++ks) cfr[ks] = *(const bf16x8*)(P.CMAT + ((size_t)g * 16 + fr) * 128 + 32 * ks + 8 * fq);
        float Ar[4], Ai[4];
#pragma unroll
        for (int q = 0; q < 4; ++q) { const int p = 16 * q + fr; Ar[q] = P.ABAR[((size_t)g * 64 + p) * 2]; Ai[q] = P.ABAR[((size_t)g * 64 + p) * 2 + 1]; }
        const f32x4 dv = *(const f32x4*)(P.dskip + 16 * g + 4 * fq);
        const int trow = 256 * (4 * wave + (fr >> 2)) + (fr & 3);
        const size_t gbase = ((size_t)b * SEQ + trow) * 1024 + 16 * g + 4 * fq;
        const bf16* up = P.U + gbase;
        float hr[4], hi[4];
#pragma unroll
        for (int q = 0; q < 4; ++q) { hr[q] = 0.f; hi[q] = 0.f; }
        {
            s16x4 ring[S5_PF];
#pragma unroll
            for (int k = 0; k < S5_PF; ++k) ring[k] = *(const s16x4*)(up + (size_t)4 * k * 1024);
            for (int tt0 = 0; tt0 < 64; tt0 += S5_PF) {
#pragma unroll
                for (int k = 0; k < S5_PF; ++k) {
                    const s16x4 uf = ring[k];
                    ring[k] = *(const s16x4*)(up + (size_t)4 * ((tt0 + k + S5_PF) & 63) * 1024);
                    f32x4 d1[8];
#pragma unroll
                    for (int st = 0; st < 8; ++st) d1[st] = __builtin_amdgcn_mfma_f32_16x16x16bf16_1k(uf, bfr[st], zero4, 0, 0, 0);
                MFMA_TO_ASM_FENCE();
#pragma unroll
                    for (int r = 0; r < 4; ++r)
#pragma unroll
                        for (int q = 0; q < 4; ++q) {
                            const float nr = fnma_s(Ai[q], hi[q], fma_s(Ar[q], hr[q], d1[q][r]));
                            const float ni = fma_s(Ai[q], hr[q], fma_s(Ar[q], hi[q], d1[q + 4][r]));
                            hr[q] = nr; hi[q] = ni;
                        }
                }
            }
        }
        const int sr = 4 * wave + fq;
#pragma unroll
        for (int q = 0; q < 4; ++q) { f32x2 v; v[0] = hr[q]; v[1] = hi[q]; *(LAS f32x2*)(EST + (sr * 64 + 16 * q + fr) * 2) = v; }
        __syncthreads();
        {
            float Pr[4], Pi[4];
#pragma unroll
            for (int q = 0; q < 4; ++q) { Pr[q] = Ar[q]; Pi[q] = Ai[q]; hr[q] = 0.f; hi[q] = 0.f; }
#pragma unroll
            for (int s = 0; s < 8; ++s)
#pragma unroll
                for (int q = 0; q < 4; ++q) { const float nr = Pr[q] * Pr[q] - Pi[q] * Pi[q], ni = 2.0f * Pr[q] * Pi[q]; Pr[q] = nr; Pi[q] = ni; }
            const int ns = 4 * wave + 3;
            for (int s_ = 0; s_ < ns; ++s_) {
                if (s_ < sr) {
#pragma unroll
                    for (int q = 0; q < 4; ++q) {
                        const f32x2 e = *(const LAS f32x2*)(EST + (s_ * 64 + 16 * q + fr) * 2);
                        const float nr = Pr[q] * hr[q] - Pi[q] * hi[q] + e[0];
                        const float ni = Pr[q] * hi[q] + Pi[q] * hr[q] + e[1];
                        hr[q] = nr; hi[q] = ni;
                    }
                }
            }
        }
        {
            s16x4 ring[S5_PF];
#pragma unroll
            for (int k = 0; k < S5_PF; ++k) ring[k] = *(const s16x4*)(up + (size_t)4 * k * 1024);
            bf16* gp = P.G + gbase;
            for (int tt0 = 0; tt0 < 64; tt0 += S5_PF) {
#pragma unroll
              for (int k = 0; k < S5_PF; ++k) {
                const int tt = tt0 + k;
                const s16x4 uf = ring[k];
                ring[k] = *(const s16x4*)(up + (size_t)4 * ((tt + S5_PF) & 63) * 1024);
                f32x4 d1[8];
#pragma unroll
                for (int st = 0; st < 8; ++st) d1[st] = __builtin_amdgcn_mfma_f32_16x16x16bf16_1k(uf, bfr[st], zero4, 0, 0, 0);
                MFMA_TO_ASM_FENCE();
#pragma unroll
                for (int r = 0; r < 4; ++r) {
#pragma unroll
                    for (int q = 0; q < 4; ++q) {
                        const float nr = fnma_s(Ai[q], hi[q], fma_s(Ar[q], hr[q], d1[q][r]));
                        const float ni = fma_s(Ai[q], hr[q], fma_s(Ar[q], hi[q], d1[q + 4][r]));
                        hr[q] = nr; hi[q] = ni;
                    }
                    u32x4 w; w.x = cvt_pk_bf16(hr[0], hr[1]); w.y = cvt_pk_bf16(hr[2], hr[3]); w.z = cvt_pk_bf16(hi[0], hi[1]); w.w = cvt_pk_bf16(hi[2], hi[3]);
                    *(LAS u32x4*)(HS + (4 * fq + r) * S5_HS_STRIDE + fr * 16) = w;
                }
                LDS_WAIT();
                f32x4 d2 = zero4;
#pragma unroll
                for (int ks = 0; ks < 4; ++ks) {
                    const bf16x8 hf = *(const LAS bf16x8*)(HS + fr * S5_HS_STRIDE + (32 * ks + 8 * fq) * 2);
                    d2 = __builtin_amdgcn_mfma_f32_16x16x32_bf16(cfr[ks], hf, d2, 0, 0, 0);
                }
                LDS_WAIT();
                float yv[4];
#pragma unroll
                for (int r = 0; r < 4; ++r) { const float uu = __builtin_bit_cast(float, ((unsigned)(unsigned short)uf[r]) << 16); yv[r] = gelu_t(d2[r] + dv[r] * uu); }
                u32x2 w; w.x = cvt_pk_bf16(yv[0], yv[1]); w.y = cvt_pk_bf16(yv[2], yv[3]);
                *(u32x2*)(gp + (size_t)4 * tt * 1024) = w;
              }
            }
        }
        __syncthreads();
    }
}

__device__ __forceinline__ void ffn_fixup_panel(const float* HALO, const float* cw, const float* cb, bf16* ACT, int pm, int tid) {
    if ((pm & 31) == 0) return;
    for (int e = tid; e < 2 * 768; e += 512) {
        const int q4 = e % 768, rho = e / 768;
        const int oc = 4 * q4, pn = oc >> 7, j = oc & 127;
        const int ta = pn * 256 + j, tg = ta + 128;
        const float* h0 = HALO + (size_t)(pm * 4) * 6144; const float* hp = HALO + (size_t)((pm - 1) * 4) * 6144;
        const f32x4 x0a = *(const f32x4*)(h0 + ta), x0g = *(const f32x4*)(h0 + tg), x1a = *(const f32x4*)(h0 + 6144 + ta), x1g = *(const f32x4*)(h0 + 6144 + tg);
        const f32x4 m2a = *(const f32x4*)(hp + 2 * 6144 + ta), m2g = *(const f32x4*)(hp + 2 * 6144 + tg), m1a = *(const f32x4*)(hp + 3 * 6144 + ta), m1g = *(const f32x4*)(hp + 3 * 6144 + tg);
        const f32x4 wa0 = *(const f32x4*)(cw + oc), wa1 = *(const f32x4*)(cw + 6144 + oc), wa2 = *(const f32x4*)(cw + 2 * 6144 + oc), ba = *(const f32x4*)(cb + oc);
        const f32x4 wg0 = *(const f32x4*)(cw + 3072 + oc), wg1 = *(const f32x4*)(cw + 6144 + 3072 + oc), wg2 = *(const f32x4*)(cw + 2 * 6144 + 3072 + oc), bg = *(const f32x4*)(cb + 3072 + oc);
        f32x4 ca, cgv;
        if (rho == 0) { ca = ba + wa2 * x0a + wa1 * m1a + wa0 * m2a; cgv = bg + wg2 * x0g + wg1 * m1g + wg0 * m2g; }
        else          { ca = ba + wa2 * x1a + wa1 * x0a + wa0 * m1a; cgv = bg + wg2 * x1g + wg1 * x0g + wg0 * m1g; }
        u32x2 w; w.x = cvt_pk_bf16(gelu_t(ca[0]) * cgv[0], gelu_t(ca[1]) * cgv[1]); w.y = cvt_pk_bf16(gelu_t(ca[2]) * cgv[2], gelu_t(ca[3]) * cgv[3]);
        *(u32x2*)(ACT + (size_t)(pm * 256 + rho) * 3072 + oc) = w;
    }
}

__device__ __forceinline__ void final_norm(const bf16* HB, const bf16* HL, float* out, const float* gfin) {
    const int lane = threadIdx.x & 63, wave = threadIdx.x >> 6;
    const int gw = blockIdx.x * NWAVES + wave, NGW = gridDim.x * NWAVES;
    f32x4 gv[4];
#pragma unroll
    for (int j = 0; j < 4; ++j) gv[j] = ((const f32x4*)gfin)[lane + 64 * j];
    for (int m0 = gw; m0 < T; m0 += 2 * NGW) {
        u32x2 hw[2][4], lw[2][4];
#pragma unroll
        for (int q = 0; q < 2; ++q) {
            const int m = (m0 + q * NGW < T) ? m0 + q * NGW : m0;
            const u32x2* hp = (const u32x2*)(HB + (size_t)m * D) + lane; const u32x2* lp = (const u32x2*)(HL + (size_t)m * D) + lane;
#pragma unroll
            for (int j = 0; j < 4; ++j) { hw[q][j] = hp[64 * j]; lw[q][j] = lp[64 * j]; }
        }
#pragma unroll
        for (int q = 0; q < 2; ++q) {
            const int m = m0 + q * NGW; if (m >= T) continue;
            f32x4 v[4]; float s = 0.f;
#pragma unroll
            for (int j = 0; j < 4; ++j) {
                const u32x2 h_ = hw[q][j], l_ = lw[q][j];
                v[j] = (f32x4){bf_lo(h_.x) + bf_lo(l_.x), bf_hi(h_.x) + bf_hi(l_.x), bf_lo(h_.y) + bf_lo(l_.y), bf_hi(h_.y) + bf_hi(l_.y)};
                s += (v[j][0] * v[j][0] + v[j][1] * v[j][1]) + (v[j][2] * v[j][2] + v[j][3] * v[j][3]);
            }
            s = wave_sum(s);
            const float rs = 1.0f / sqrtf(s * (1.0f / 1024.0f) + 1e-6f);
            f32x4* xr = (f32x4*)(out + (size_t)m * D) + lane;
#pragma unroll
            for (int j = 0; j < 4; ++j) xr[64 * j] = v[j] * rs * gv[j];
        }
    }
}

__device__ __forceinline__ void fill_rs_table(LAS float* rsl, const pg8::StaticOrder& S, const float* rowsq) {
    int tid_ = threadIdx.x; asm volatile("" : "+v"(tid_));
    const int r = tid_ & 255, half = tid_ >> 8;
    for (int i0 = 0; i0 < 12; i0 += 2) {
        pg8::Unit uu;
        if (S.next(i0 + half, uu)) rsl[(i0 + half) * 256 + r] = pg8::row_rs(rowsq, uu.pm * 256 + r);
    }
    __syncthreads();
}

#define GSYNC() xcd_barrier(xbar)
__global__ void __launch_bounds__(NWAVES * 64, 2) mega_fwd(Args a) {
    extern __shared__ __attribute__((aligned(16))) unsigned char lds_raw[];
    cg::grid_group grid = cg::this_grid();
    LAS unsigned char* lds = (LAS unsigned char*)lds_raw;
    unsigned char* ws = a.ws;
    bf16* HB = (bf16*)(ws + WS_HB);
    bf16* HL = (bf16*)(ws + WS_HL);
    float* rowsq = (float*)(ws + WS_ROWSQ);
    bf16* B0 = (bf16*)(ws + WS_BIG);
    bf16* B1 = (bf16*)(ws + WS_BIG + 64 * MiB);
    bf16* B2 = (bf16*)(ws + WS_BIG + 128 * MiB);
    const int G = gridDim.x, c = blockIdx.x;

    {
        volatile LAS unsigned* st = (volatile LAS unsigned*)(lds + LDS_BYTES - 64);
        if (threadIdx.x < 16) st[threadIdx.x] = 0u;
        __syncthreads();
    }
    XcdBarrier xbar = xcd_barrier_post((unsigned*)(ws + WS_CTL), (volatile LAS unsigned*)(lds + LDS_BYTES - 64));
    prologue(lds, a);
    xcd_barrier(xbar);
    if (gridDim.y == 0x7fffu) grid.sync();

#pragma unroll 1
    for (int layer = 0; layer < 4; ++layer) {
        const int j = layer >> 1;
        if ((layer & 1) == 0) {
            {
                pg8::Gemm g{HB, (const bf16*)(ws + WS_RG_WIN) + (size_t)j * 2048 * 1024, T, 2048, 1024}; pg8::StaticOrder S; S.init(T, 2048, G, c);
                fill_rs_table((LAS float*)(lds + pg8::STAGE_BYTES + 12288), S, rowsq);
                pg8::EpiRsBf16 E{B0, B1, 4, (LAS const float*)(lds + pg8::STAGE_BYTES + 12288)};
                pg8::gemm_phase<pg8::EpiRsBf16, pg8::StaticOrder, true, true>(lds, g, S, E);
            }
            GSYNC();
            RgP P{B0, B1, B2, (float*)(ws + WS_SUMM), (const bf16*)(ws + WS_GATES) + (size_t)(j * 2 + 0) * 8 * 128 * 128, (const bf16*)(ws + WS_GATES) + (size_t)(j * 2 + 1) * 8 * 128 * 128,
                  a.in[8] + j * 1024, a.in[10] + j * 1024, a.in[11] + j * 1024, a.in[5] + j * 4 * 1024, a.in[6] + j * 1024};
            rg_mixer<0>(lds, P);
            GSYNC();
            rg_mixer<1>(lds, P);
            GSYNC();
            {
                pg8::Gemm g{B2, (const bf16*)(ws + WS_RG_WOUT) + (size_t)j * 1024 * 1024, T, 1024, 1024}; pg8::StaticOrder S; S.init(T, 1024, G, c);
                pg8::EpiResid E{layer == 0 ? a.in[0] : nullptr, HB, HL, rowsq};
                pg8::gemm_phase<pg8::EpiResid, pg8::StaticOrder, true, true>(lds, g, S, E);
            }
            GSYNC();
        } else {
            {
                pg8::Gemm g{HB, (const bf16*)(ws + WS_S5_WIN) + (size_t)j * 1024 * 1024, T, 1024, 1024}; pg8::StaticOrder S; S.init(T, 1024, G, c);
                fill_rs_table((LAS float*)(lds + pg8::STAGE_BYTES + 12288), S, rowsq);
                pg8::EpiRsBf16 E{B0, B0, 4, (LAS const float*)(lds + pg8::STAGE_BYTES + 12288)};
                pg8::gemm_phase<pg8::EpiRsBf16, pg8::StaticOrder, true, true>(lds, g, S, E);
            }
            GSYNC();
            {
                S5P P{B0, B1, (const float*)(ws + WS_ABAR) + (size_t)j * 64 * 64 * 2, (const bf16*)(ws + WS_BBAR) + (size_t)j * 64 * 128 * 16, (const bf16*)(ws + WS_CMAT) + (size_t)j * 64 * 16 * 128, a.in[21] + j * 1024};
                s5_mixer(lds, P);
            }
            GSYNC();
            {
                pg8::Gemm g{B1, (const bf16*)(ws + WS_S5_WGLU) + (size_t)j * 2048 * 1024, T, 2048, 1024}; pg8::StaticOrder S; S.init(T, 2048, G, c);
                pg8::EpiGlu E{B2};
                pg8::gemm_phase<pg8::EpiGlu, pg8::StaticOrder, true, true>(lds, g, S, E);
            }
            GSYNC();
            {
                pg8::Gemm g{B2, (const bf16*)(ws + WS_S5_WOUT) + (size_t)j * 1024 * 1024, T, 1024, 1024}; pg8::StaticOrder S; S.init(T, 1024, G, c);
                pg8::EpiResid E{nullptr, HB, HL, rowsq};
                pg8::gemm_phase<pg8::EpiResid, pg8::StaticOrder, true, true>(lds, g, S, E);
            }
            GSYNC();
        }
        const float* fcw = a.in[25] + (size_t)layer * 3 * 6144; const float* fcb = a.in[26] + (size_t)layer * 6144;
        {
            pg8::Gemm g{HB, (const bf16*)(ws + WS_FFN_WUP) + (size_t)layer * 6144 * 1024, T, 6144, 1024}; pg8::StaticOrder S; S.init(T, 6144, G, c);
            fill_rs_table((LAS float*)(lds + pg8::STAGE_BYTES + 12288), S, rowsq);
            pg8::EpiFfnUp E{B0, (float*)(ws + WS_HALO), rowsq, fcw, fcb, (LAS float*)(lds + pg8::STAGE_BYTES), (LAS float*)(lds + pg8::STAGE_BYTES + 8192)};
            pg8::gemm_phase<pg8::EpiFfnUp, pg8::StaticOrder, true, true>(lds, g, S, E);
        }
        GSYNC();
        {
            pg8::Gemm g{B0, (const bf16*)(ws + WS_FFN_WDN) + (size_t)layer * 1024 * 3072, T, 1024, 3072}; pg8::StaticOrder S; S.init(T, 1024, G, c);
            {
                int tid_ = threadIdx.x; asm volatile("" : "+v"(tid_));
                pg8::Unit uu; int last_pm = -1;
                for (int i = 0; S.next(i, uu); ++i) { if (uu.pm != last_pm) ffn_fixup_panel((const float*)(ws + WS_HALO), fcw, fcb, B0, uu.pm, tid_); last_pm = uu.pm; }
                asm volatile("s_waitcnt vmcnt(0)" ::: "memory");
                __syncthreads();
            }
            pg8::EpiResid E{nullptr, HB, HL, rowsq};
            pg8::gemm_phase<pg8::EpiResid, pg8::StaticOrder, true, true>(lds, g, S, E);
        }
        GSYNC();
    }
    final_norm(HB, HL, a.out, a.in[3]);
}

extern "C" void kernel_launch(void* const* d_in, const int* in_sizes, int n_in, void* d_out, int out_size, void* d_ws, size_t ws_size, hipStream_t stream) {
    static int grid = 0;
    if (grid == 0) {
        if (n_in != 28 || in_sizes[0] != T * D || out_size != T * D || ws_size < WS_END) {
            fprintf(stderr, "kernel_launch: unexpected problem (n_in %d, in0 %d, out %d, ws %zu < %zu)\n", n_in, n_in > 0 ? in_sizes[0] : -1, out_size, ws_size, (size_t)WS_END); grid = -1; return; }
        int dev = 0, cus = 0, per_cu = 0;
        (void)hipGetDevice(&dev);
        (void)hipDeviceGetAttribute(&cus, hipDeviceAttributeMultiprocessorCount, dev);
        if (hipFuncSetAttribute((const void*)mega_fwd, hipFuncAttributeMaxDynamicSharedMemorySize, LDS_BYTES) != hipSuccess) { fprintf(stderr, "kernel_launch: hipFuncSetAttribute failed\n"); grid = -1; return; }
        if (hipOccupancyMaxActiveBlocksPerMultiprocessor(&per_cu, (const void*)mega_fwd, NWAVES * 64, LDS_BYTES) != hipSuccess || per_cu < 1) { fprintf(stderr, "kernel_launch: occupancy query says %d blocks per CU\n", per_cu); (void)hipGetLastError(); per_cu = 1; }
        grid = cus * 1;
        if (grid > 256) grid = 256;
    }
    if (grid < 0) return;
    Args a{};
    for (int i = 0; i < 28; ++i) a.in[i] = (const float*)d_in[i];
    a.out = (float*)d_out; a.ws = (unsigned char*)d_ws;
    void* args[] = {&a};
    if (hipMemsetAsync((char*)d_ws + WS_CTL, 0, CTL_ZERO_BYTES, stream) != hipSuccess) { fprintf(stderr, "kernel_launch: memset of the barrier words failed\n"); return; }
    const hipError_t e = hipLaunchCooperativeKernel((const void*)mega_fwd, dim3(grid), dim3(NWAVES * 64), args, LDS_BYTES, stream);
    if (e != hipSuccess) fprintf(stderr, "kernel_launch: cooperative launch failed: %s (grid %d)\n", hipGetErrorString(e), grid);
}
```

```cpp
#include <hip/hip_runtime.h>
#include <hip/hip_cooperative_groups.h>
#include <cstdio>
#include <cstdint>
namespace cg = cooperative_groups;

namespace pg8 {
#define PG8_LAS __attribute__((address_space(3)))
typedef unsigned short bf16_t;
typedef short bf16x8 __attribute__((ext_vector_type(8)));
typedef float f32x4 __attribute__((ext_vector_type(4)));
typedef unsigned u32x4 __attribute__((ext_vector_type(4)));
typedef unsigned u32x2 __attribute__((ext_vector_type(2)));
constexpr int BM = 256, BK = 64, HALF = 128, HTB = HALF * BK * 2  , STAGE_BYTES = 8 * HTB, NXCD = 8, WGM = 8;

__host__ __device__ __forceinline__ int lds_byte(int r, int c) { const int st = (r >> 4) * 2 + (c >> 5), rr = r & 15, cc = c & 31, ob = rr * 64 + cc * 2; return st * 1024 + (ob ^ (((ob >> 9) & 1) << 5)); }
__host__ __device__ __forceinline__ void stage_rc(int b, int& R, int& C) { const int st = b / 1024, sb = b % 1024, swz = sb ^ (((sb >> 9) & 1) << 5); R = (st >> 1) * 16 + swz / 64; C = (st & 1) * 32 + (swz % 64) / 2; }
__host__ __device__ __forceinline__ int perm32(int rho) { const int n = rho >> 4, i = rho & 15; return 8 * (i >> 2) + 4 * n + (i & 3); }

struct Unit { int pm, pn, idx; };
struct Gemm { const bf16_t* A; const bf16_t* Bt; int M, N, K; };

struct StaticOrder {
    int nM, nN, nwg, G, c;
    __host__ __device__ void init(int M, int N, int G_, int c_) { nM = M / BM; nN = N / BM; nwg = nM * nN; G = G_; c = c_; }
    __host__ __device__ bool next(int i, Unit& u) const {
        const long L = (long)i * G + c; if (L >= nwg) return false;
        int wgid = (int)L; { const int q = nwg / NXCD, r = nwg % NXCD, xcd = wgid % NXCD, off = wgid / NXCD; wgid = (xcd < r ? xcd * (q + 1) : r * (q + 1) + (xcd - r) * q) + off; }
        const int nig = WGM * nN, gid = wgid / nig, fm = gid * WGM, gsz = (nM - fm) < WGM ? (nM - fm) : WGM;
        u.pm = fm + ((wgid % nig) % gsz); u.pn = (wgid % nig) / gsz; u.idx = i; return true;
    }
    __device__ __forceinline__ void a_ready(const Unit&) const {}
    __device__ __forceinline__ void done(const Unit&) const {}
};

__device__ __forceinline__ unsigned cvt_pk_bf16(float lo, float hi) { unsigned r; asm volatile("v_cvt_pk_bf16_f32 %0, %1, %2" : "=v"(r) : "v"(lo), "v"(hi)); return r; }
__device__ __forceinline__ float fsigmoid(float x) { return __builtin_amdgcn_rcpf(1.0f + __builtin_amdgcn_exp2f(-1.4426950408889634f * x)); }
__device__ __forceinline__ float gelu_t(float x) { const float y = x * (1.5957691216057308f + 0.0713548162726009f * x * x); return x * fsigmoid(y); }
__device__ __forceinline__ float bf_lo(unsigned w) { return __builtin_bit_cast(float, w << 16); }
__device__ __forceinline__ float bf_hi(unsigned w) { return __builtin_bit_cast(float, w & 0xffff0000u); }
typedef float f32x2 __attribute__((ext_vector_type(2)));
__device__ __forceinline__ f32x2 gelu_gate_pk(f32x2 v, f32x2 g) {
    const f32x2 z = v * ((v * v) * (-0.0713548162726009f * 1.4426950408889634f) + (-1.5957691216057308f * 1.4426950408889634f));
    f32x2 e; e.x = __builtin_amdgcn_exp2f(z.x); e.y = __builtin_amdgcn_exp2f(z.y);
    const f32x2 d = e + 1.0f;
    f32x2 r; r.x = __builtin_amdgcn_rcpf(d.x); r.y = __builtin_amdgcn_rcpf(d.y);
    return (v * g) * r;
}
__device__ __forceinline__ float dpp_prev1(float cur, float prev) {
    const int rot = __builtin_amdgcn_update_dpp(0, __builtin_bit_cast(int, prev), 0x121, 0xf, 0xf, false);
    return __builtin_bit_cast(float, __builtin_amdgcn_update_dpp(rot, __builtin_bit_cast(int, cur), 0x111, 0xf, 0xf, false));
}
__device__ __forceinline__ float dpp_prev2(float cur, float prev) {
    const int rot = __builtin_amdgcn_update_dpp(0, __builtin_bit_cast(int, prev), 0x122, 0xf, 0xf, false);
    return __builtin_bit_cast(float, __builtin_amdgcn_update_dpp(rot, __builtin_bit_cast(int, cur), 0x112, 0xf, 0xf, false));
}
__device__ __forceinline__ float row_rs(const float* rowsq, int row) {
    const f32x4* p = (const f32x4*)(rowsq + (size_t)row * 16);
    const f32x4 a = p[0], b = p[1], c = p[2], d = p[3];
    const float s = (((a[0] + a[1]) + (a[2] + a[3])) + ((b[0] + b[1]) + (b[2] + b[3]))) + (((c[0] + c[1]) + (c[2] + c[3])) + ((d[0] + d[1]) + (d[2] + d[3])));
    return __builtin_amdgcn_rsqf(s * (1.0f / 1024.0f) + 1e-6f);
}

__device__ __forceinline__ float row_ssq_part(const float* rowsq, int row, int fq) { const f32x4 a = *(const f32x4*)(rowsq + (size_t)row * 16 + 4 * fq); return (a[0] + a[1]) + (a[2] + a[3]); }
__device__ __forceinline__ float row_rs_fin(float s) { s += __shfl_xor(s, 16); s += __shfl_xor(s, 32); return __builtin_amdgcn_rsqf(s * (1.0f / 1024.0f) + 1e-6f); }


struct EpiRsBf16 {
    static constexpr bool PERM = true, AFTER_DRAIN = false, PERM_A = false;
    bf16_t* O0; bf16_t* O1; int split_pn; PG8_LAS const float* rsl;
    __device__ __forceinline__ void operator()(const f32x4 (&acc)[2][2][4][2], const Unit& u, int wr, int wc, int fr, int fq) const {
        const bool second = u.pn >= split_pn;
        bf16_t* base = second ? O1 : O0;
        const int col0 = (u.pn & 3) * BM + wc * 32 + 8 * fq;
        const int row0 = u.pm * BM + wr * 64 + fr;
#pragma unroll
        for (int ai = 0; ai < 2; ++ai)
#pragma unroll
            for (int m = 0; m < 4; ++m) {
                const int row = row0 + ai * HALF + m * 16;
                const float rs = rsl[u.idx * 256 + wr * 64 + fr + ai * HALF + m * 16];
                bf16_t* rowp = base + (size_t)row * 1024 + col0;
#pragma unroll
                for (int bj = 0; bj < 2; ++bj) {
                    f32x4 v0 = acc[ai][bj][m][0] * rs, v1 = acc[ai][bj][m][1] * rs;
                    if (second) {
#pragma unroll
                        for (int e = 0; e < 4; ++e) { v0[e] = gelu_t(v0[e]); v1[e] = gelu_t(v1[e]); }
                    }
                    u32x4 w; w.x = cvt_pk_bf16(v0[0], v0[1]); w.y = cvt_pk_bf16(v0[2], v0[3]); w.z = cvt_pk_bf16(v1[0], v1[1]); w.w = cvt_pk_bf16(v1[2], v1[3]);
                    *(u32x4*)(rowp + bj * HALF) = w;
                }
            }
    }
};

struct EpiResid {
    static constexpr bool PERM = true, AFTER_DRAIN = false, PERM_A = false;
    const float* xbase; bf16_t* HB; bf16_t* HL; float* rowsq;
    __device__ __forceinline__ void operator()(const f32x4 (&acc)[2][2][4][2], const Unit& u, int wr, int wc, int fr, int fq) const {
        const int col0 = u.pn * BM + wc * 32 + 8 * fq;
        const int row0 = u.pm * BM + wr * 64 + fr;
#pragma unroll
        for (int ai = 0; ai < 2; ++ai)
#pragma unroll
            for (int m = 0; m < 4; ++m) {
                const int row = row0 + ai * HALF + m * 16;
                const size_t off = (size_t)row * 1024 + col0;
                float ss = 0.f;
#pragma unroll
                for (int bj = 0; bj < 2; ++bj) {
                    const size_t o = off + bj * HALF;
                    f32x4 b0, b1;
                    if (xbase) { b0 = *(const f32x4*)(xbase + o); b1 = *(const f32x4*)(xbase + o + 4); }
                    else { const u32x4 hw = *(const u32x4*)(HB + o), lw = *(const u32x4*)(HL + o);
                           b0 = (f32x4){bf_lo(hw.x) + bf_lo(lw.x), bf_hi(hw.x) + bf_hi(lw.x), bf_lo(hw.y) + bf_lo(lw.y), bf_hi(hw.y) + bf_hi(lw.y)};
                           b1 = (f32x4){bf_lo(hw.z) + bf_lo(lw.z), bf_hi(hw.z) + bf_hi(lw.z), bf_lo(hw.w) + bf_lo(lw.w), bf_hi(hw.w) + bf_hi(lw.w)}; }
                    const f32x4 v0 = b0 + acc[ai][bj][m][0], v1 = b1 + acc[ai][bj][m][1];
                    ss += ((v0[0] * v0[0] + v0[1] * v0[1]) + (v0[2] * v0[2] + v0[3] * v0[3])) + ((v1[0] * v1[0] + v1[1] * v1[1]) + (v1[2] * v1[2] + v1[3] * v1[3]));
                    u32x4 h; h.x = cvt_pk_bf16(v0[0], v0[1]); h.y = cvt_pk_bf16(v0[2], v0[3]); h.z = cvt_pk_bf16(v1[0], v1[1]); h.w = cvt_pk_bf16(v1[2], v1[3]);
                    u32x4 l; l.x = cvt_pk_bf16(v0[0] - bf_lo(h.x), v0[1] - bf_hi(h.x)); l.y = cvt_pk_bf16(v0[2] - bf_lo(h.y), v0[3] - bf_hi(h.y));
                    l.z = cvt_pk_bf16(v1[0] - bf_lo(h.z), v1[1] - bf_hi(h.z)); l.w = cvt_pk_bf16(v1[2] - bf_lo(h.w), v1[3] - bf_hi(h.w));
                    *(u32x4*)(HB + o) = h; *(u32x4*)(HL + o) = l;
                }
                ss += __shfl_xor(ss, 16); ss += __shfl_xor(ss, 32);
                if (fq == 0) rowsq[(size_t)row * 16 + u.pn * 4 + wc] = ss;
            }
    }
};

struct EpiGlu {
    static constexpr bool PERM = true, AFTER_DRAIN = false, PERM_A = false;
    bf16_t* O;
    __device__ __forceinline__ void operator()(const f32x4 (&acc)[2][2][4][2], const Unit& u, int wr, int wc, int fr, int fq) const {
        const int col0 = u.pn * HALF + wc * 32 + 8 * fq;
        const int row0 = u.pm * BM + wr * 64 + fr;
#pragma unroll
        for (int ai = 0; ai < 2; ++ai)
#pragma unroll
            for (int m = 0; m < 4; ++m) {
                const int row = row0 + ai * HALF + m * 16;
                f32x4 v0, v1;
#pragma unroll
                for (int e = 0; e < 4; ++e) { v0[e] = acc[ai][0][m][0][e] * fsigmoid(acc[ai][1][m][0][e]); v1[e] = acc[ai][0][m][1][e] * fsigmoid(acc[ai][1][m][1][e]); }
                u32x4 w; w.x = cvt_pk_bf16(v0[0], v0[1]); w.y = cvt_pk_bf16(v0[2], v0[3]); w.z = cvt_pk_bf16(v1[0], v1[1]); w.w = cvt_pk_bf16(v1[2], v1[3]);
                *(u32x4*)(O + (size_t)row * 1024 + col0) = w;
            }
    }
};

struct EpiFfnUp {
    static constexpr bool PERM = true, AFTER_DRAIN = false, PERM_A = true;
    bf16_t* ACT; float* HALO; const float* rowsq; const float* cw; const float* cb; PG8_LAS float* ex; PG8_LAS float* wl;
    __device__ __forceinline__ void operator()(f32x4 (&acc)[2][2][4][2], const Unit& u, int wr, int wc, int fr_, int fq_) const {
        int fr = fr_, fq = fq_; asm volatile("" : "+v"(fr), "+v"(fq));
        const int lane = fr + 16 * fq;
        const int rowt = wr * 64 + 4 * fr, colt = wc * 32 + 8 * fq;
        const int tid = 64 * (4 * wr + wc) + lane, tc = tid & 255, p2 = tid >> 8;
        const int upc = (tc < HALF) ? (u.pn * HALF + tc) : (3072 + u.pn * HALF + (tc - HALF));
        const float wl_a = cw[p2 * 6144 + upc], wl_b = (p2 == 0) ? cw[2 * 6144 + upc] : cb[upc];
#pragma unroll
        for (int ai = 0; ai < 2; ++ai)
#pragma unroll
            for (int m = 0; m < 4; ++m) {
                const float rs = (ex + 3072)[u.idx * 256 + ai * HALF + rowt + m];
#pragma unroll
                for (int bj = 0; bj < 2; ++bj)
#pragma unroll
                    for (int n = 0; n < 2; ++n) acc[ai][bj][m][n] = acc[ai][bj][m][n] * rs;
                asm volatile("" : "+v"(acc[ai][0][m][0]), "+v"(acc[ai][0][m][1]), "+v"(acc[ai][1][m][0]), "+v"(acc[ai][1][m][1]));
            }
        if (fr == 15) {
#pragma unroll
            for (int ai = 0; ai < 2; ++ai)
#pragma unroll
                for (int bj = 0; bj < 2; ++bj)
#pragma unroll
                    for (int n = 0; n < 2; ++n)
#pragma unroll
                        for (int w = 0; w < 2; ++w) {
                            const f32x4 x = acc[ai][bj][2 + w][n];
                            *(PG8_LAS f32x4*)(ex + ((2 * ai + wr) * 2 + w) * 256 + bj * HALF + colt + 4 * n) = x;
                            if (ai == 1 && wr == 1) *(f32x4*)(HALO + ((size_t)(u.pm * 4 + 2 + w)) * 6144 + u.pn * BM + bj * HALF + colt + 4 * n) = x;
                        }
        }
        if (wr == 0 && fr == 0) {
#pragma unroll
            for (int bj = 0; bj < 2; ++bj)
#pragma unroll
                for (int n = 0; n < 2; ++n)
#pragma unroll
                    for (int w = 0; w < 2; ++w)
                        *(f32x4*)(HALO + ((size_t)(u.pm * 4 + w)) * 6144 + u.pn * BM + bj * HALF + colt + 4 * n) = acc[0][bj][w][n];
        }
        wl[p2 * 256 + tc] = wl_a; wl[(p2 + 2) * 256 + tc] = wl_b;
        asm volatile("s_waitcnt lgkmcnt(0)" ::: "memory"); __builtin_amdgcn_s_barrier(); asm volatile("" ::: "memory");
#pragma unroll
        for (int n = 0; n < 2; ++n) {
            const int oc = u.pn * HALF + colt + 4 * n;
            PG8_LAS const float* wp = wl + colt + 4 * n;
            const f32x4 wa0 = *(PG8_LAS const f32x4*)(wp), wa1 = *(PG8_LAS const f32x4*)(wp + 256), wa2 = *(PG8_LAS const f32x4*)(wp + 512), ba = *(PG8_LAS const f32x4*)(wp + 768);
            const f32x4 wg0 = *(PG8_LAS const f32x4*)(wp + HALF), wg1 = *(PG8_LAS const f32x4*)(wp + 256 + HALF), wg2 = *(PG8_LAS const f32x4*)(wp + 512 + HALF), bg = *(PG8_LAS const f32x4*)(wp + 768 + HALF);
#pragma unroll
            for (int ai = 0; ai < 2; ++ai) {
                const int idx = 2 * ai + wr;
                f32x4 h2a = {0.f, 0.f, 0.f, 0.f}, h1a = h2a, h2g = h2a, h1g = h2a;
                if (idx > 0) {
                    const PG8_LAS float* e0 = ex + ((idx - 1) * 2) * 256 + colt + 4 * n;
                    h2a = *(const PG8_LAS f32x4*)(e0); h2g = *(const PG8_LAS f32x4*)(e0 + HALF);
                    h1a = *(const PG8_LAS f32x4*)(e0 + 256); h1g = *(const PG8_LAS f32x4*)(e0 + 256 + HALF);
                }
                f32x4 s2a, s3a, s2g, s3g;
#pragma unroll
                for (int e = 0; e < 4; ++e) {
                    float d2a, d3a, d2g, d3g;
                    asm("v_mov_b32_dpp %0, %1 row_shr:1 row_mask:0xf bank_mask:0xf bound_ctrl:1" : "=v"(d2a) : "v"(acc[ai][0][2][n][e]));
                    asm("v_mov_b32_dpp %0, %1 row_shr:1 row_mask:0xf bank_mask:0xf bound_ctrl:1" : "=v"(d3a) : "v"(acc[ai][0][3][n][e]));
                    asm("v_mov_b32_dpp %0, %1 row_shr:1 row_mask:0xf bank_mask:0xf bound_ctrl:1" : "=v"(d2g) : "v"(acc[ai][1][2][n][e]));
                    asm("v_mov_b32_dpp %0, %1 row_shr:1 row_mask:0xf bank_mask:0xf bound_ctrl:1" : "=v"(d3g) : "v"(acc[ai][1][3][n][e]));
                    s2a[e] = (fr == 0) ? h2a[e] : d2a; s3a[e] = (fr == 0) ? h1a[e] : d3a;
                    s2g[e] = (fr == 0) ? h2g[e] : d2g; s3g[e] = (fr == 0) ? h1g[e] : d3g;
                }
#pragma unroll
                for (int m = 0; m < 4; ++m) {
                    const f32x4 xa = acc[ai][0][m][n], xg = acc[ai][1][m][n];
                    const f32x4 p1a = (m == 0) ? s3a : acc[ai][0][m > 0 ? m - 1 : 0][n], p1g = (m == 0) ? s3g : acc[ai][1][m > 0 ? m - 1 : 0][n];
                    const f32x4 p2a = (m == 0) ? s2a : (m == 1) ? s3a : acc[ai][0][m > 1 ? m - 2 : 0][n], p2g = (m == 0) ? s2g : (m == 1) ? s3g : acc[ai][1][m > 1 ? m - 2 : 0][n];
                    const f32x4 ca = ba + wa2 * xa + wa1 * p1a + wa0 * p2a;
                    const f32x4 cgv = bg + wg2 * xg + wg1 * p1g + wg0 * p2g;
                    const f32x2 o01 = gelu_gate_pk((f32x2){ca[0], ca[1]}, (f32x2){cgv[0], cgv[1]}), o23 = gelu_gate_pk((f32x2){ca[2], ca[3]}, (f32x2){cgv[2], cgv[3]});
                    u32x2 w; w.x = cvt_pk_bf16(o01.x, o01.y); w.y = cvt_pk_bf16(o23.x, o23.y);
                    *(u32x2*)(ACT + (size_t)(u.pm * BM + ai * HALF + rowt + m) * 3072 + oc) = w;
                }
            }
        }
    }
};

template <class Epi, class Sched, bool ALIGN_EPI = false, bool SP2 = false>
__device__ __forceinline__ void gemm_phase(PG8_LAS unsigned char* lds, const Gemm g, const Sched& S, const Epi& E) {
    int tid_ = threadIdx.x; asm volatile("" : "+v"(tid_)); const int tid = tid_, wid = __builtin_amdgcn_readfirstlane(tid >> 6), lane = tid & 63, wr = wid >> 2, wc = wid & 3, fr = lane & 15, fq = lane >> 4;
    const int K = g.K, nt = K / BK;
    unsigned voffA[2], voffB[2];
#pragma unroll
    for (int i = 0; i < 2; ++i) { int R, C; stage_rc(tid * 16 + i * 8192, R, C); const int Rb = Epi::PERM ? ((R & ~31) + perm32(R & 31)) : R;
        const int Ra = Epi::PERM_A ? ((R & 64) | (4 * (R & 15) + ((R >> 4) & 3))) : R; voffA[i] = (unsigned)(Ra * K + C) * 2u; voffB[i] = (unsigned)(Rb * K + C) * 2u; }
    const size_t kstep = (size_t)(BK * 2);
    const size_t hstep = (size_t)HALF * K * 2;
    const size_t tstep = 2 * hstep;
    const unsigned ldsw = (unsigned)wid * 1024u;
    const int aoff = lds_byte(wr * 64 + fr, fq * 8), boff = lds_byte(wc * 32 + fr, fq * 8);
#define PG8_SA(b, h) (((b) * 2 + (h)) * HTB)
#define PG8_SB(b, h) ((4 + (b) * 2 + (h)) * HTB)
#define PG8_STAGE(bufoff, gbase, voff) do { _Pragma("unroll") for (int _i = 0; _i < 2; ++_i) \
        __builtin_amdgcn_global_load_lds((const unsigned*)((const char*)(gbase) + (voff)[_i]), (PG8_LAS unsigned*)(lds + (bufoff) + ldsw + _i * 8192), 16, 0, 0); } while (0)
#define PG8_LDA(dst, b, h) do { _Pragma("unroll") for (int m = 0; m < 4; ++m) _Pragma("unroll") for (int k = 0; k < 2; ++k) dst[m][k] = *(const PG8_LAS bf16x8*)(lds + PG8_SA(b, h) + aoff + m * 2048 + k * 1024); } while (0)
#define PG8_LDB(dst, b, h) do { _Pragma("unroll") for (int n = 0; n < 2; ++n) _Pragma("unroll") for (int k = 0; k < 2; ++k) dst[n][k] = *(const PG8_LAS bf16x8*)(lds + PG8_SB(b, h) + boff + n * 2048 + k * 1024); } while (0)
#define PG8_MMA(ai, bj, At, Bt) do { __builtin_amdgcn_s_setprio(1); _Pragma("unroll") for (int m = 0; m < 4; ++m) _Pragma("unroll") for (int n = 0; n < 2; ++n) _Pragma("unroll") for (int k = 0; k < 2; ++k) \
        acc[ai][bj][m][n] = __builtin_amdgcn_mfma_f32_16x16x32_bf16(Bt[n][k], At[m][k], acc[ai][bj][m][n], 0, 0, 0); __builtin_amdgcn_s_setprio(0); } while (0)
#define PG8_WAIT_V(n) asm volatile("s_waitcnt vmcnt(" #n ")" ::: "memory")
#define PG8_WAIT_L(n) asm volatile("s_waitcnt lgkmcnt(" #n ")" ::: "memory")
#define PG8_BAR __builtin_amdgcn_s_barrier()
#define PG8_SCHED __builtin_amdgcn_sched_barrier(0)
    Unit cur, nxt; int ui = 0;
    if (!S.next(0, cur)) return;
    f32x4 acc[2][2][4][2];
#pragma unroll
    for (int a = 0; a < 2; ++a)
#pragma unroll
        for (int b = 0; b < 2; ++b)
#pragma unroll
            for (int m = 0; m < 4; ++m)
#pragma unroll
                for (int n = 0; n < 2; ++n) acc[a][b][m][n] = (f32x4){0.f, 0.f, 0.f, 0.f};
    bf16x8 At[4][2], B0[2][2], B1[2][2];
    const char* cA = (const char*)g.A + (size_t)cur.pm * tstep; const char* cB = (const char*)g.Bt + (size_t)cur.pn * tstep;
    S.a_ready(cur);
    if constexpr (SP2) {
        PG8_STAGE(PG8_SB(0, 0), cB, voffB); PG8_STAGE(PG8_SB(0, 1), cB + hstep, voffB); PG8_STAGE(PG8_SA(0, 0), cA, voffA); PG8_STAGE(PG8_SA(0, 1), cA + hstep, voffA);
        if (wr == 1) PG8_BAR;
        PG8_WAIT_V(2); PG8_BAR;
        PG8_STAGE(PG8_SB(1, 0), cB + kstep, voffB); PG8_STAGE(PG8_SA(1, 0), cA + kstep, voffA); PG8_STAGE(PG8_SB(1, 1), cB + hstep + kstep, voffB);
        PG8_WAIT_V(6); PG8_BAR;
    } else {
        PG8_STAGE(PG8_SB(0, 0), cB, voffB); PG8_STAGE(PG8_SA(0, 0), cA, voffA); PG8_STAGE(PG8_SB(0, 1), cB + hstep, voffB); PG8_STAGE(PG8_SA(0, 1), cA + hstep, voffA);
        if (wr == 1) PG8_BAR;
        PG8_WAIT_V(4); PG8_BAR;
        PG8_STAGE(PG8_SB(1, 0), cB + kstep, voffB); PG8_STAGE(PG8_SA(1, 0), cA + kstep, voffA); PG8_STAGE(PG8_SB(1, 1), cB + hstep + kstep, voffB);
        PG8_WAIT_V(6); PG8_BAR;
    }
    for (;;) {
        const bool has_next = S.next(ui + 1, nxt);
        const char* nA = has_next ? (const char*)g.A + (size_t)nxt.pm * tstep : cA; const char* nB = has_next ? (const char*)g.Bt + (size_t)nxt.pn * tstep : cB;
        for (int t = 0; t < nt; t += 2) {
            const bool last = (t == nt - 2);
            const char* a1 = cA + (size_t)(t + 1) * kstep;
            const char* a2 = last ? nA : cA + (size_t)(t + 2) * kstep; const char* b2 = last ? nB : cB + (size_t)(t + 2) * kstep;
            const char* a3 = a2 + kstep; const char* b3 = b2 + kstep;
            if (last && has_next) S.a_ready(nxt);
            if constexpr (SP2) {
            PG8_LDB(B0, 0, 0); PG8_LDB(B1, 0, 1); PG8_SCHED; PG8_LDA(At, 0, 0); PG8_STAGE(PG8_SA(1, 1), a1 + hstep, voffA);
            PG8_WAIT_V(8); PG8_WAIT_L(0); PG8_BAR; PG8_MMA(0, 0, At, B0); PG8_MMA(0, 1, At, B1); PG8_BAR; PG8_SCHED;
            PG8_LDA(At, 0, 1); PG8_STAGE(PG8_SB(0, 0), b2, voffB); PG8_STAGE(PG8_SB(0, 1), b2 + hstep, voffB); PG8_STAGE(PG8_SA(0, 0), a2, voffA);
            PG8_WAIT_V(8); PG8_WAIT_L(0); PG8_BAR; PG8_MMA(1, 0, At, B0); PG8_MMA(1, 1, At, B1); PG8_BAR; PG8_SCHED;
            PG8_LDB(B0, 1, 0); PG8_LDB(B1, 1, 1); PG8_SCHED; PG8_LDA(At, 1, 0); PG8_STAGE(PG8_SA(0, 1), a2 + hstep, voffA);
            PG8_WAIT_V(8); PG8_WAIT_L(0); PG8_BAR; PG8_MMA(0, 0, At, B0); PG8_MMA(0, 1, At, B1); PG8_BAR; PG8_SCHED;
            PG8_LDA(At, 1, 1); PG8_STAGE(PG8_SB(1, 0), b3, voffB); PG8_STAGE(PG8_SB(1, 1), b3 + hstep, voffB); PG8_STAGE(PG8_SA(1, 0), a3, voffA);
            PG8_WAIT_V(8); PG8_WAIT_L(0); PG8_BAR; PG8_MMA(1, 0, At, B0); PG8_MMA(1, 1, At, B1); PG8_BAR; PG8_SCHED;
            } else {
            PG8_LDB(B0, 0, 0); PG8_SCHED; PG8_LDA(At, 0, 0); PG8_STAGE(PG8_SA(1, 1), a1 + hstep, voffA);
            PG8_WAIT_L(8); PG8_BAR; PG8_WAIT_L(0); PG8_MMA(0, 0, At, B0); PG8_BAR; PG8_SCHED;
            PG8_LDB(B1, 0, 1); PG8_STAGE(PG8_SB(0, 0), b2, voffB);
            PG8_BAR; PG8_WAIT_L(0); PG8_MMA(0, 1, At, B1); PG8_BAR;
            PG8_LDA(At, 0, 1); PG8_STAGE(PG8_SA(0, 0), a2, voffA);
            PG8_BAR; PG8_WAIT_L(0); PG8_MMA(1, 0, At, B0); PG8_BAR; PG8_SCHED;
            PG8_STAGE(PG8_SB(0, 1), b2 + hstep, voffB);
            PG8_WAIT_V(6); PG8_BAR; PG8_MMA(1, 1, At, B1); PG8_BAR;
            PG8_LDB(B0, 1, 0); PG8_SCHED; PG8_LDA(At, 1, 0); PG8_STAGE(PG8_SA(0, 1), a2 + hstep, voffA);
            PG8_WAIT_L(8); PG8_BAR; PG8_WAIT_L(0); PG8_MMA(0, 0, At, B0); PG8_BAR; PG8_SCHED;
            PG8_LDB(B1, 1, 1); PG8_STAGE(PG8_SB(1, 0), b3, voffB);
            PG8_BAR; PG8_WAIT_L(0); PG8_MMA(0, 1, At, B1); PG8_BAR;
            PG8_LDA(At, 1, 1); PG8_STAGE(PG8_SA(1, 0), a3, voffA);
            PG8_BAR; PG8_WAIT_L(0); PG8_MMA(1, 0, At, B0); PG8_BAR; PG8_SCHED;
            PG8_STAGE(PG8_SB(1, 1), b3 + hstep, voffB);
            PG8_WAIT_V(6); PG8_BAR; PG8_MMA(1, 1, At, B1); PG8_BAR;
            }
        }
        if constexpr (ALIGN_EPI) { if (wr == 0) PG8_BAR; }
        if constexpr (!Epi::AFTER_DRAIN) { E(acc, cur, wr, wc, fr, fq); S.done(cur); }
        if (!has_next) break;
#pragma unroll
        for (int a = 0; a < 2; ++a)
#pragma unroll
            for (int b = 0; b < 2; ++b)
#pragma unroll
                for (int m = 0; m < 4; ++m)
#pragma unroll
                    for (int n = 0; n < 2; ++n) acc[a][b][m][n] = (f32x4){0.f, 0.f, 0.f, 0.f};
        cur = nxt; cA = nA; cB = nB; ++ui;
        if constexpr (ALIGN_EPI) { if (wr == 1) PG8_BAR; }
    }
    PG8_WAIT_V(0);
    if constexpr (!ALIGN_EPI) { if (wr == 0) PG8_BAR; }
    PG8_BAR;
    if constexpr (Epi::AFTER_DRAIN) { E.fused(acc, cur, wr, wc, fr, fq, lds, wid, lane); S.done(cur); }
#undef PG8_SA
#undef PG8_SB
#undef PG8_STAGE
#undef PG8_LDA
#undef PG8_LDB
#undef PG8_MMA
#undef PG8_WAIT_V
#undef PG8_WAIT_L
#undef PG8_BAR
#undef PG8_SCHED
}
}

#define LAS __attribute__((address_space(3)))
typedef unsigned short bf16;
typedef pg8::f32x4 f32x4;
typedef pg8::u32x4 u32x4;
typedef pg8::u32x2 u32x2;
typedef pg8::bf16x8 bf16x8;
typedef short s16x4 __attribute__((ext_vector_type(4)));
typedef float f32x2 __attribute__((ext_vector_type(2)));
using pg8::cvt_pk_bf16; using pg8::fsigmoid; using pg8::gelu_t; using pg8::bf_lo; using pg8::bf_hi;

constexpr int T = 32768, D = 1024, SEQ = 8192, NWAVES = 8;
constexpr int LDS_BYTES = 163840;
constexpr size_t MiB = 1u << 20;
constexpr size_t WS_CTL = 0, CTL_ZERO_BYTES = 65536;
constexpr size_t WS_ABAR = 1 * MiB;
constexpr size_t WS_BBAR = 1 * MiB + 256 * 1024;
constexpr size_t WS_CMAT = 2 * MiB;
constexpr size_t WS_GATES = 3 * MiB;
constexpr size_t WS_SUMM = 4 * MiB;
constexpr size_t WS_ROWSQ = 6 * MiB;
constexpr size_t WS_RG_WIN = 8 * MiB;
constexpr size_t WS_RG_WOUT = 16 * MiB;
constexpr size_t WS_S5_WIN = 20 * MiB;
constexpr size_t WS_S5_WGLU = 24 * MiB;
constexpr size_t WS_S5_WOUT = 32 * MiB;
constexpr size_t WS_FFN_WUP = 36 * MiB;
constexpr size_t WS_FFN_WDN = 84 * MiB;
constexpr size_t WS_HALO = 108 * MiB;
constexpr size_t WS_HB = 120 * MiB;
constexpr size_t WS_BIG = 184 * MiB;
constexpr size_t WS_HL = 376 * MiB;
constexpr size_t WS_END = 440 * MiB;

struct Args { const float* in[28]; float* out; unsigned char* ws; };

__device__ __forceinline__ float wave_sum(float v) {
#pragma unroll
    for (int o = 1; o < 64; o <<= 1) v += __shfl_xor(v, o);
    return v;
}
__device__ __forceinline__ unsigned f2bf(float f) { unsigned u = __builtin_bit_cast(unsigned, f); return (u + 0x7fffu + ((u >> 16) & 1u)) >> 16; }
__device__ __forceinline__ unsigned pk2(float lo, float hi) { return f2bf(lo) | (f2bf(hi) << 16); }
#define LDS_WAIT() asm volatile("s_waitcnt lgkmcnt(0)" ::: "memory")

#define XB_TMO      128
#define XB_XCNT(j)  (256  + 64 * (j))
#define XB_XSUB(j)  (1280 + 64 * (j))
#define XB_XGEN(j)  (2304 + 64 * (j))
#define XB_TOP      3328
#define XB_TOPGEN   3392
#define XCD_BAR_WORDS 3456
#define XB_SPIN_CAP (1u << 18)

__device__ __forceinline__ unsigned xb_ld(unsigned* p)              { return __hip_atomic_load(p, __ATOMIC_RELAXED, __HIP_MEMORY_SCOPE_AGENT); }
__device__ __forceinline__ unsigned xb_add(unsigned* p, unsigned v) { return __hip_atomic_fetch_add(p, v, __ATOMIC_RELAXED, __HIP_MEMORY_SCOPE_AGENT); }
__device__ __forceinline__ unsigned xb_xcc_id() { return (unsigned)__builtin_amdgcn_s_getreg((3 << 11) | 20) & 0xFu; }
#define XB_SPIN(cond, bar) do { unsigned _sp = 0; while (cond) { __builtin_amdgcn_s_sleep(1); \
    if ((++_sp & 255u) == 0u) { if (xb_ld(&(bar)[XB_TMO])) break; if (_sp > XB_SPIN_CAP) { atomicAdd(&(bar)[XB_TMO], 1u); break; } } } } while (0)

struct XcdBarrier {
    unsigned* bar; unsigned x;
    volatile LAS unsigned* st;
};

__device__ __forceinline__ XcdBarrier xcd_barrier_post(unsigned* bar, volatile LAS unsigned* st) {
    XcdBarrier b; b.bar = bar; b.x = xb_xcc_id(); b.st = st;
    if (threadIdx.x == 0) (void)xb_add(&bar[XB_XCNT(b.x)], 1u);
    return b;
}
__device__ __forceinline__ void xcd_barrier_complete(unsigned* bar, unsigned x, unsigned& nloc, unsigned& nx) {
    const unsigned G = gridDim.x * gridDim.y * gridDim.z;
    unsigned sum, cnt, mine, sp = 0u;
    for (;;) {
        sum = 0u; cnt = 0u; mine = 0u;
#pragma unroll
        for (unsigned j = 0; j < 16; ++j) { const unsigned c = xb_ld(&bar[XB_XCNT(j)]); sum += c; cnt += (c > 0u) ? 1u : 0u; mine = (j == x) ? c : mine; }
        if (sum == G) break;
        __builtin_amdgcn_s_sleep(1);
        if ((++sp & 255u) == 0u) { if (xb_ld(&bar[XB_TMO])) break; if (sp > XB_SPIN_CAP) { atomicAdd(&bar[XB_TMO], 1u); break; } }
    }
    nloc = mine > 0u ? mine : 1u; nx = cnt > 0u ? cnt : 1u;
}

__device__ __forceinline__ void xcd_barrier(const XcdBarrier& b) {
    asm volatile("s_waitcnt vmcnt(0)" ::: "memory");
    __syncthreads();
    if (threadIdx.x == 0) {
        unsigned* bar = b.bar;
        __builtin_amdgcn_s_waitcnt(0);
        unsigned nloc = b.st[0], nx = b.st[1];
        if (nloc == 0u) { xcd_barrier_complete(bar, b.x, nloc, nx); b.st[0] = nloc; b.st[1] = nx; }
        const unsigned old = xb_add(&bar[XB_XSUB(b.x)], 1u);
        const unsigned gen = old / nloc;
        if (old + 1u == (gen + 1u) * nloc) {
            __builtin_amdgcn_fence(__ATOMIC_RELEASE, "agent");
            asm volatile("s_waitcnt vmcnt(0)" ::: "memory");
            const unsigned og = xb_add(&bar[XB_TOP], 1u);
            const unsigned tg = og / nx;
            if (og + 1u == (tg + 1u) * nx) xb_add(&bar[XB_TOPGEN], 1u);
            else XB_SPIN(xb_ld(&bar[XB_TOPGEN]) == tg, bar);
            __builtin_amdgcn_fence(__ATOMIC_ACQUIRE, "agent");
            xb_add(&bar[XB_XGEN(b.x)], 1u);
            asm volatile("s_waitcnt vmcnt(0)" ::: "memory");
        } else {
            XB_SPIN(xb_ld(&bar[XB_XGEN(b.x)]) == gen, bar);
            __builtin_amdgcn_fence(__ATOMIC_ACQUIRE, "agent");
            asm volatile("s_waitcnt vmcnt(0)" ::: "memory");
        }
    }
    __syncthreads();
}

__device__ __forceinline__ void transpose_item(const float* W, int K, int N, bf16* WT, const float* gain, int pair_half, LAS float* scr, int item, int lane, float scale = 1.0f) {
    const int nblk = N / 32, kb = item / nblk, nb = item % nblk, k0 = 64 * kb, n0 = 32 * nb;
    float wv[32];
#pragma unroll
    for (int i = 0; i < 32; ++i) wv[i] = W[(size_t)(k0 + 2 * i + (lane >> 5)) * N + n0 + (lane & 31)];
    if (gain) {
#pragma unroll
        for (int i = 0; i < 32; ++i) wv[i] *= gain[k0 + 2 * i + (lane >> 5)];
    }
    if (scale != 1.0f) {
#pragma unroll
        for (int i = 0; i < 32; ++i) wv[i] *= scale;
    }
#pragma unroll
    for (int i = 0; i < 32; ++i) scr[(2 * i + (lane >> 5)) * 33 + (lane & 31)] = wv[i];
    LDS_WAIT(); asm volatile("" ::: "memory");
    int dn0 = n0;
    if (pair_half) dn0 = (n0 < pair_half) ? (256 * (n0 / 128) + (n0 % 128)) : (256 * ((n0 - pair_half) / 128) + 128 + ((n0 - pair_half) % 128));
    const int c = lane & 7;
#pragma unroll
    for (int j = 0; j < 4; ++j) {
        const int n = (lane >> 3) + 8 * j; const LAS float* s = scr + (8 * c) * 33 + n;
        u32x4 o; o.x = pk2(s[0 * 33], s[1 * 33]); o.y = pk2(s[2 * 33], s[3 * 33]); o.z = pk2(s[4 * 33], s[5 * 33]); o.w = pk2(s[6 * 33], s[7 * 33]);
        *(u32x4*)(WT + (size_t)(dn0 + n) * K + k0 + 8 * c) = o;
    }
    LDS_WAIT(); asm volatile("" ::: "memory");
}

__device__ __forceinline__ void prologue(LAS unsigned char* lds, const Args& a) {
    int tid_ = threadIdx.x; asm volatile("" : "+v"(tid_));
    const int tid = tid_, lane = tid & 63, wave = tid >> 6;
    unsigned char* ws = a.ws;
    LAS float* scr = (LAS float*)(lds + wave * 16384);
    const int gw = blockIdx.x * NWAVES + wave, NGW = gridDim.x * NWAVES;
    constexpr int I_UP = 16 * 192, I_DN = 48 * 32, I_2K = 16 * 64, I_1K = 16 * 32, I_G = 2 * 4;
    constexpr int S0 = 4 * I_UP, S1 = S0 + 4 * I_DN, S2 = S1 + 2 * I_2K, S3 = S2 + 2 * I_2K, S4 = S3 + 2 * I_1K, S5 = S4 + 2 * I_1K, S6 = S5 + 2 * I_1K, S7 = S6 + 32 * I_G;
    for (int it = gw; it < S7; it += NGW) {
        if (it < S0) { const int i = it / I_UP, r = it % I_UP;
            transpose_item(a.in[24] + (size_t)i * 1024 * 6144, 1024, 6144, (bf16*)(ws + WS_FFN_WUP) + (size_t)i * 6144 * 1024, a.in[2] + i * 1024, 3072, scr, r, lane); }
        else if (it < S1) { const int i = (it - S0) / I_DN, r = (it - S0) % I_DN;
            transpose_item(a.in[27] + (size_t)i * 3072 * 1024, 3072, 1024, (bf16*)(ws + WS_FFN_WDN) + (size_t)i * 1024 * 3072, nullptr, 0, scr, r, lane); }
        else if (it < S2) { const int j = (it - S1) / I_2K, r = (it - S1) % I_2K;
            transpose_item(a.in[4] + (size_t)j * 1024 * 2048, 1024, 2048, (bf16*)(ws + WS_RG_WIN) + (size_t)j * 2048 * 1024, a.in[1] + (2 * j) * 1024, 0, scr, r, lane); }
        else if (it < S3) { const int j = (it - S2) / I_2K, r = (it - S2) % I_2K;
            transpose_item(a.in[22] + (size_t)j * 1024 * 2048, 1024, 2048, (bf16*)(ws + WS_S5_WGLU) + (size_t)j * 2048 * 1024, nullptr, 1024, scr, r, lane); }
        else if (it < S4) { const int j = (it - S3) / I_1K, r = (it - S3) % I_1K;
            transpose_item(a.in[12] + (size_t)j * 1024 * 1024, 1024, 1024, (bf16*)(ws + WS_RG_WOUT) + (size_t)j * 1024 * 1024, nullptr, 0, scr, r, lane); }
        else if (it < S5) { const int j = (it - S4) / I_1K, r = (it - S4) % I_1K;
            transpose_item(a.in[13] + (size_t)j * 1024 * 1024, 1024, 1024, (bf16*)(ws + WS_S5_WIN) + (size_t)j * 1024 * 1024, a.in[1] + (2 * j + 1) * 1024, 0, scr, r, lane); }
        else if (it < S6) { const int j = (it - S5) / I_1K, r = (it - S5) % I_1K;
            transpose_item(a.in[23] + (size_t)j * 1024 * 1024, 1024, 1024, (bf16*)(ws + WS_S5_WOUT) + (size_t)j * 1024 * 1024, nullptr, 0, scr, r, lane); }
        else { const int mtx = (it - S6) / I_G, r = (it - S6) % I_G;
            const int layer = mtx >> 4, gate = (mtx >> 3) & 1, head = mtx & 7;
            const float* src = (gate ? a.in[9] : a.in[7]) + ((size_t)layer * 8 + head) * 128 * 128;
            transpose_item(src, 128, 128, (bf16*)(ws + WS_GATES) + (size_t)mtx * 128 * 128, nullptr, 0, scr, r, lane, -1.4426950408889634f); }
    }
    for (int e = blockIdx.x * 512 + tid; e < 2 * 64 * 64; e += gridDim.x * 512) {
        const int p = e & 63, jg = e >> 6;
        const float ar = a.in[14][e], ai = a.in[15][e], dt = expf(a.in[16][jg]);
        const float mag = expf(ar * dt), ang = ai * dt;
        const float abr = mag * cosf(ang), abi = mag * sinf(ang);
        float* AB = (float*)(ws + WS_ABAR); AB[2 * e] = abr; AB[2 * e + 1] = abi;
        const float ur = abr - 1.0f, ui = abi, den = ar * ar + ai * ai;
        const float wr_ = (ur * ar + ui * ai) / den, wi_ = (ui * ar - ur * ai) / den;
        bf16* BB = (bf16*)(ws + WS_BBAR) + (size_t)jg * 128 * 16;
        const float* bre = a.in[17] + (size_t)e * 16; const float* bim = a.in[18] + (size_t)e * 16;
#pragma unroll
        for (int c = 0; c < 16; ++c) {
            const float br = bre[c], bi = bim[c];
            BB[p * 16 + c] = (bf16)f2bf(wr_ * br - wi_ * bi);
            BB[(64 + p) * 16 + c] = (bf16)f2bf(wr_ * bi + wi_ * br);
        }
        bf16* CM = (bf16*)(ws + WS_CMAT) + (size_t)jg * 16 * 128;
        const int kq = 8 * (p & 15) + (p >> 4);
#pragma unroll
        for (int c = 0; c < 16; ++c) {
            CM[c * 128 + kq] = (bf16)f2bf(a.in[19][((size_t)jg * 16 + c) * 64 + p]);
            CM[c * 128 + kq + 4] = (bf16)f2bf(-a.in[20][((size_t)jg * 16 + c) * 64 + p]);
        }
    }
    {
        const float* x = a.in[0]; bf16* HB = (bf16*)(ws + WS_HB); float* rowsq = (float*)(ws + WS_ROWSQ);
        for (int m0 = gw; m0 < T; m0 += 4 * NGW) {
            f32x4 v[4][4];
#pragma unroll
            for (int q = 0; q < 4; ++q) { const int m = m0 + q * NGW; const f32x4* xr = (const f32x4*)(x + (size_t)(m < T ? m : m0) * D) + lane;
#pragma unroll
                for (int j = 0; j < 4; ++j) v[q][j] = xr[64 * j]; }
#pragma unroll
            for (int q = 0; q < 4; ++q) {
                const int m = m0 + q * NGW; if (m >= T) continue;
                float s = 0.f;
#pragma unroll
                for (int j = 0; j < 4; ++j) s += (v[q][j][0] * v[q][j][0] + v[q][j][1] * v[q][j][1]) + (v[q][j][2] * v[q][j][2] + v[q][j][3] * v[q][j][3]);
                s = wave_sum(s);
                u32x2* o8 = (u32x2*)(HB + (size_t)m * D) + lane;
#pragma unroll
                for (int j = 0; j < 4; ++j) { u32x2 w; w.x = cvt_pk_bf16(v[q][j][0], v[q][j][1]); w.y = cvt_pk_bf16(v[q][j][2], v[q][j][3]); o8[64 * j] = w; }
                if (lane < 16) rowsq[(size_t)m * 16 + lane] = (lane == 0) ? s : 0.f;
            }
        }
    }
}

struct RgP { const bf16* XR; const bf16* GG; bf16* Y; float* SUMM; const bf16* WA; const bf16* WX; const float* ba; const float* bx; const float* lam; const float* cw; const float* cb; };
constexpr int RG_STRIDE = 528, RG_TILE = 64 * RG_STRIDE, RG_XS = 0, RG_GY = 2 * RG_TILE;

template <int PASS>
__device__ __forceinline__ void rg_issue(const RgP& P, size_t growb, int t0, int chl, u32x4 (&xraw)[7], u32x4 (&ggraw)[4]) {
#pragma unroll
    for (int d = 0; d < 7; ++d) {
        const int tt = t0 - 3 + d;
        const u32x4 raw = *(const u32x4*)(P.XR + (growb + (tt < 0 ? 0 : tt)) * 1024 + chl);
        xraw[d] = (tt < 0) ? (u32x4){0u, 0u, 0u, 0u} : raw;
    }
    if (PASS == 1) {
#pragma unroll
        for (int r = 0; r < 4; ++r) ggraw[r] = *(const u32x4*)(P.GG + (growb + t0 + r) * 1024 + chl);
    }
}
template <int PASS>
__device__ __forceinline__ void rg_commit(LAS unsigned char* lds, const RgP& P, int buf, int rho0, int cc, int chl_, const u32x4 (&xraw)[7], const u32x4 (&ggraw)[4]) {
    int chl = chl_; asm volatile("" : "+v"(chl));
    f32x4 cwv[4][2], cbv[2];
#pragma unroll
    for (int d = 0; d < 4; ++d) { cwv[d][0] = *(const f32x4*)(P.cw + d * 1024 + chl); cwv[d][1] = *(const f32x4*)(P.cw + d * 1024 + chl + 4); }
    cbv[0] = *(const f32x4*)(P.cb + chl); cbv[1] = *(const f32x4*)(P.cb + chl + 4);
#pragma unroll
    for (int r = 0; r < 4; ++r) {
        f32x4 o0 = cbv[0], o1 = cbv[1];
#pragma unroll
        for (int d = 0; d < 4; ++d) {
            const u32x4 raw = xraw[r + d];
            const f32x4 x0 = {bf_lo(raw.x), bf_hi(raw.x), bf_lo(raw.y), bf_hi(raw.y)}, x1 = {bf_lo(raw.z), bf_hi(raw.z), bf_lo(raw.w), bf_hi(raw.w)};
            o0 += cwv[d][0] * x0; o1 += cwv[d][1] * x1;
        }
        u32x4 w; w.x = cvt_pk_bf16(o0[0], o0[1]); w.y = cvt_pk_bf16(o0[2], o0[3]); w.z = cvt_pk_bf16(o1[0], o1[1]); w.w = cvt_pk_bf16(o1[2], o1[3]);
        *(LAS u32x4*)(lds + RG_XS + buf * RG_TILE + (rho0 + r) * RG_STRIDE + cc * 16) = w;
        if (PASS == 1) *(LAS u32x4*)(lds + RG_GY + buf * RG_TILE + (rho0 + r) * RG_STRIDE + cc * 16) = ggraw[r];
    }
}

template <int PASS>
__device__ __forceinline__ void rg_mixer(LAS unsigned char* lds, const RgP& P) {
    int tid_ = threadIdx.x; asm volatile("" : "+v"(tid_));
    const int tid = tid_, lane = tid & 63, wave = tid >> 6, fr = lane & 15, fq = lane >> 4;
    const int hl = wave >> 2, slice = wave & 3;
    for (int unit = blockIdx.x; unit < 256; unit += gridDim.x) {
        const int b = unit >> 6, sc = (unit >> 2) & 15, cgp = unit & 3;
        const int chw = 256 * cgp + 128 * hl + 32 * slice, head = 2 * cgp + hl;
        const int colw = 128 * hl + 32 * slice + fr;
        bf16x8 bA[2][4], bX[2][4];
#pragma unroll
        for (int nt = 0; nt < 2; ++nt)
#pragma unroll
            for (int ks = 0; ks < 4; ++ks) {
                const size_t o = ((size_t)head * 128 + 32 * slice + 16 * nt + fr) * 128 + 32 * ks + 8 * fq;
                bA[nt][ks] = *(const bf16x8*)(P.WA + o); bX[nt][ks] = *(const bf16x8*)(P.WX + o);
            }
        float gba[2], gbx[2], sp[2], hc[2], pc[2];
#pragma unroll
        for (int nt = 0; nt < 2; ++nt) {
            const int ch = chw + 16 * nt + fr;
            gba[nt] = -1.4426950408889634f * P.ba[ch]; gbx[nt] = -1.4426950408889634f * P.bx[ch];
            sp[nt] = 8.0f * 1.4426950408889634f * log1pf(expf(-P.lam[ch]));
            hc[nt] = 0.f; pc[nt] = 1.f;
        }
        if (PASS == 1) {
            const int ns = 4 * sc + 3;
            LAS f32x2* SL = (LAS f32x2*)lds;
            for (int e = tid; e < ns * 256; e += 512) { const int s_ = e >> 8, c = e & 255; SL[e] = *(const f32x2*)(P.SUMM + (((size_t)b * 64 + s_) * 1024 + 256 * cgp + c) * 2); }
            __syncthreads();
            const int sub = 4 * sc + fq;
            for (int s_ = 0; s_ < ns; ++s_) {
                if (s_ < sub) {
#pragma unroll
                    for (int nt = 0; nt < 2; ++nt) { const f32x2 v = SL[s_ * 256 + colw + 16 * nt]; hc[nt] = v[0] * hc[nt] + v[1]; }
                }
            }
            __syncthreads();
        }
        const int cc = tid & 31, li = tid >> 5;
        const int chl = 256 * cgp + 8 * cc;
        const int rho0 = 16 * (li & 3) + 4 * (li >> 2);
        const int tq0 = 512 * sc + 128 * (li >> 2) + 4 * (li & 3);
        const size_t growb = (size_t)b * SEQ;
        u32x4 xraw[7], ggraw[4];
        if (PASS == 1) {
            rg_issue<PASS>(P, growb, tq0, chl, xraw, ggraw);
            rg_commit<PASS>(lds, P, 0, rho0, cc, chl, xraw, ggraw);
            __syncthreads();
        }
#pragma unroll 1
        for (int step = 0; step < 8; ++step) {
            const int buf = step & 1;
            if (PASS == 0) {
                rg_issue<PASS>(P, growb, tq0 + 16 * step, chl, xraw, ggraw);
                rg_commit<PASS>(lds, P, buf, rho0, cc, chl, xraw, ggraw);
                __syncthreads();
            }
            if (PASS == 1 && step < 7) rg_issue<PASS>(P, growb, tq0 + 16 * (step + 1), chl, xraw, ggraw);
            if (PASS == 1 && step > 0) {
#pragma unroll
                for (int r = 0; r < 4; ++r)
                    *(u32x4*)(P.Y + (growb + tq0 + 16 * (step - 1) + r) * 1024 + chl) = *(const LAS u32x4*)(lds + RG_GY + (buf ^ 1) * RG_TILE + (rho0 + r) * RG_STRIDE + cc * 16);
            }
            const LAS unsigned char* xs = lds + RG_XS + buf * RG_TILE;
            LAS unsigned char* gy = lds + RG_GY + buf * RG_TILE;
#pragma unroll
            for (int mt = 0; mt < 4; ++mt) {
                bf16x8 af[4];
#pragma unroll
                for (int ks = 0; ks < 4; ++ks) af[ks] = *(const LAS bf16x8*)(xs + (16 * mt + fr) * RG_STRIDE + (128 * hl + 32 * ks + 8 * fq) * 2);
                f32x4 accA[2], accX[2];
#pragma unroll
                for (int nt = 0; nt < 2; ++nt) { accA[nt] = (f32x4){gba[nt], gba[nt], gba[nt], gba[nt]}; accX[nt] = (f32x4){gbx[nt], gbx[nt], gbx[nt], gbx[nt]}; }
#pragma unroll
                for (int ks = 0; ks < 4; ++ks)
#pragma unroll
                    for (int nt = 0; nt < 2; ++nt) {
                        accA[nt] = __builtin_amdgcn_mfma_f32_16x16x32_bf16(af[ks], bA[nt][ks], accA[nt], 0, 0, 0);
                        accX[nt] = __builtin_amdgcn_mfma_f32_16x16x32_bf16(af[ks], bX[nt][ks], accX[nt], 0, 0, 0);
                    }
#pragma unroll
                for (int nt = 0; nt < 2; ++nt)
#pragma unroll
                    for (int r = 0; r < 4; ++r) {
                        const int rho = 16 * mt + 4 * fq + r, col = colw + 16 * nt;
                        const float xr = __builtin_bit_cast(float, (unsigned)(*(const LAS unsigned short*)(xs + rho * RG_STRIDE + col * 2)) << 16);
                        const float rg = __builtin_amdgcn_rcpf(1.0f + __builtin_amdgcn_exp2f(accA[nt][r])), ig = __builtin_amdgcn_rcpf(1.0f + __builtin_amdgcn_exp2f(accX[nt][r]));
                        const float av = __builtin_amdgcn_exp2f(-sp[nt] * rg);
                        const float mult = __builtin_amdgcn_sqrtf(fmaxf(1.0f - av * av, 0.f));
                        hc[nt] = av * hc[nt] + mult * (ig * xr);
                        if (PASS == 0) pc[nt] *= av;
                        if (PASS == 1) {
                            LAS unsigned short* gp = (LAS unsigned short*)(gy + rho * RG_STRIDE + col * 2);
                            const float gyv = __builtin_bit_cast(float, (unsigned)(*gp) << 16);
                            *gp = (unsigned short)f2bf(hc[nt] * gyv);
                        }
                    }
                __builtin_amdgcn_sched_barrier(0);
            }
            if (PASS == 1) { if (step < 7) rg_commit<PASS>(lds, P, buf ^ 1, rho0, cc, chl, xraw, ggraw); __syncthreads(); }
        }
        if (PASS == 1) {
#pragma unroll
            for (int r = 0; r < 4; ++r)
                *(u32x4*)(P.Y + (growb + tq0 + 16 * 7 + r) * 1024 + chl) = *(const LAS u32x4*)(lds + RG_GY + 1 * RG_TILE + (rho0 + r) * RG_STRIDE + cc * 16);
        }
        if (PASS == 0) {
            const int sub = 4 * sc + fq;
#pragma unroll
            for (int nt = 0; nt < 2; ++nt) { f32x2 v; v[0] = pc[nt]; v[1] = hc[nt]; *(f32x2*)(P.SUMM + (((size_t)b * 64 + sub) * 1024 + chw + 16 * nt + fr) * 2) = v; }
        }
        __syncthreads();
    }
}


__device__ __forceinline__ float fma_s(float a, float b, float c) { float r; asm("v_fma_f32 %0, %1, %2, %3" : "=v"(r) : "v"(a), "v"(b), "v"(c)); return r; }
__device__ __forceinline__ float fnma_s(float a, float b, float c) { float r; asm("v_fma_f32 %0, -%1, %2, %3" : "=v"(r) : "v"(a), "v"(b), "v"(c)); return r; }
#define MFMA_TO_ASM_FENCE() do { __builtin_amdgcn_sched_barrier(0); asm volatile("s_nop 15\n\ts_nop 3" ::: "memory"); __builtin_amdgcn_sched_barrier(0); } while (0)
struct S5P { const bf16* U; bf16* G; const float* ABAR; const bf16* BBAR; const bf16* CMAT; const float* dskip; };
constexpr int S5_PF = 8;
constexpr int S5_HS_STRIDE = 272, S5_HS_WAVE = 16 * 272, S5_EST = 36864;

__device__ __forceinline__ void s5_mixer(LAS unsigned char* lds, const S5P& P) {
    int tid_ = threadIdx.x; asm volatile("" : "+v"(tid_));
    const int tid = tid_, lane = tid & 63, wave = tid >> 6, fr = lane & 15, fq = lane >> 4;
    LAS unsigned char* HS = lds + wave * S5_HS_WAVE;
    LAS float* EST = (LAS float*)(lds + S5_EST);
    const f32x4 zero4 = {0.f, 0.f, 0.f, 0.f};
    for (int unit = blockIdx.x; unit < 256; unit += gridDim.x) {
        const int b = unit >> 6, g = unit & 63;
        s16x4 bfr[8];
#pragma unroll
        for (int st = 0; st < 8; ++st) bfr[st] = *(const s16x4*)(P.BBAR + ((size_t)g * 128 + 16 * st + fr) * 16 + 4 * fq);
        bf16x8 cfr[4];
#pragma unroll
        for (int ks = 0; ks < 4; ++ks) cfr[ks] = *(const bf16x8*)(P.CMAT + ((size_t)g * 16 + fr) * 128 + 32 * ks + 8 * fq);
        float Ar[4], Ai[4];
#pragma unroll
        for (int q = 0; q < 4; ++q) { const int p = 16 * q + fr; Ar[q] = P.ABAR[((size_t)g * 64 + p) * 2]; Ai[q] = P.ABAR[((size_t)g * 64 + p) * 2 + 1]; }
        const f32x4 dv = *(const f32x4*)(P.dskip + 16 * g + 4 * fq);
        const int trow = 256 * (4 * wave + (fr >> 2)) + (fr & 3);
        const size_t gbase = ((size_t)b * SEQ + trow) * 1024 + 16 * g + 4 * fq;
        const bf16* up = P.U + gbase;
        float hr[4], hi[4];
#pragma unroll
        for (int q = 0; q < 4; ++q) { hr[q] = 0.f; hi[q] = 0.f; }
        {
            s16x4 ring[S5_PF];
#pragma unroll
            for (int k = 0; k < S5_PF; ++k) ring[k] = *(const s16x4*)(up + (size_t)4 * k * 1024);
            for (int tt0 = 0; tt0 < 64; tt0 += S5_PF) {
#pragma unroll
                for (int k = 0; k < S5_PF; ++k) {
                    const s16x4 uf = ring[k];
                    ring[k] = *(const s16x4*)(up + (size_t)4 * ((tt0 + k + S5_PF) & 63) * 1024);
                    f32x4 d1[8];
#pragma unroll
                    for (int st = 0; st < 8; ++st) d1[st] = __builtin_amdgcn_mfma_f32_16x16x16bf16_1k(uf, bfr[st], zero4, 0, 0, 0);
                MFMA_TO_ASM_FENCE();
#pragma unroll
                    for (int r = 0; r < 4; ++r)
#pragma unroll
                        for (int q = 0; q < 4; ++q) {
                            const float nr = fnma_s(Ai[q], hi[q], fma_s(Ar[q], hr[q], d1[q][r]));
                            const float ni = fma_s(Ai[q], hr[q], fma_s(Ar[q], hi[q], d1[q + 4][r]));
                            hr[q] = nr; hi[q] = ni;
                        }
                }
            }
        }
        const int sr = 4 * wave + fq;
#pragma unroll
        for (int q = 0; q < 4; ++q) { f32x2 v; v[0] = hr[q]; v[1] = hi[q]; *(LAS f32x2*)(EST + (sr * 64 + 16 * q + fr) * 2) = v; }
        __syncthreads();
        {
            float Pr[4], Pi[4];
#pragma unroll
            for (int q = 0; q < 4; ++q) { Pr[q] = Ar[q]; Pi[q] = Ai[q]; hr[q] = 0.f; hi[q] = 0.f; }
#pragma unroll
            for (int s = 0; s < 8; ++s)
#pragma unroll
                for (int q = 0; q < 4; ++q) { const float nr = Pr[q] * Pr[q] - Pi[q] * Pi[q], ni = 2.0f * Pr[q] * Pi[q]; Pr[q] = nr; Pi[q] = ni; }
            const int ns = 4 * wave + 3;
            for (int s_ = 0; s_ < ns; ++s_) {
                if (s_ < sr) {
#pragma unroll
                    for (int q = 0; q < 4; ++q) {
                        const f32x2 e = *(const LAS f32x2*)(EST + (s_ * 64 + 16 * q + fr) * 2);
                        const float nr = Pr[q] * hr[q] - Pi[q] * hi[q] + e[0];
                        const float ni = Pr[q] * hi[q] + Pi[q] * hr[q] + e[1];
                        hr[q] = nr; hi[q] = ni;
                    }
                }
            }
        }
        {
            s16x4 ring[S5_PF];
#pragma unroll
            for (int k = 0; k < S5_PF; ++k) ring[k] = *(const s16x4*)(up + (size_t)4 * k * 1024);
            bf16* gp = P.G + gbase;
            for (int tt0 = 0; tt0 < 64; tt0 += S5_PF) {
#pragma unroll
              for (int k = 0; k < S5_PF; ++k) {
                const int tt = tt0 + k;
                const s16x4 uf = ring[k];
                ring[k] = *(const s16x4*)(up + (size_t)4 * ((tt + S5_PF) & 63) * 1024);
                f32x4 d1[8];
#pragma unroll
                for (int st = 0; st < 8; ++st) d1[st] = __builtin_amdgcn_mfma_f32_16x16x16bf16_1k(uf, bfr[st], zero4, 0, 0, 0);
                MFMA_TO_ASM_FENCE();
#pragma unroll
                for (int r = 0; r < 4; ++r) {
#pragma unroll
                    for (int q = 0; q < 4; ++q) {
                        const float nr = fnma_s(Ai[q], hi[q], fma_s(Ar[q], hr[q], d1[q][r]));
                        const float ni = fma_s(Ai[q], hr[q], fma_s(Ar[q], hi[q], d1[q + 4][r]));
                        hr[q] = nr; hi[q] = ni;
                    }
                    u32x4 w; w.x = cvt_pk_bf16(hr[0], hr[1]); w.y = cvt_pk_bf16(hr[2], hr[3]); w.z = cvt_pk_bf16(hi[0], hi[1]); w.w = cvt_pk_bf16(hi[2], hi[3]);
                    *(LAS u32x4*)(HS + (4 * fq + r) * S5_HS_STRIDE + fr * 16) = w;
                }
                LDS_WAIT();
                f32x4 d2 = zero4;
#pragma unroll
                for (int ks = 0; ks < 4; ++ks) {
                    const bf16x8 hf = *(const LAS bf16x8*)(HS + fr * S5_HS_STRIDE + (32 * ks + 8 * fq) * 2);
                    d2 = __builtin_amdgcn_mfma_f32_16x16x32_bf16(cfr[ks], hf, d2, 0, 0, 0);
                }
                LDS_WAIT();
                float yv[4];
#pragma unroll
                for (int r = 0; r < 4; ++r) { const float uu = __builtin_bit_cast(float, ((unsigned)(unsigned short)uf[r]) << 16); yv[r] = gelu_t(d2[r] + dv[r] * uu); }
                u32x2 w; w.x = cvt_pk_bf16(yv[0], yv[1]); w.y = cvt_pk_bf16(yv[2], yv[3]);
                *(u32x2*)(gp + (size_t)4 * tt * 1024) = w;
              }
            }
        }
        __syncthreads();
    }
}

__device__ __forceinline__ void ffn_fixup_panel(const float* HALO, const float* cw, const float* cb, bf16* ACT, int pm, int tid) {
    if ((pm & 31) == 0) return;
    for (int e = tid; e < 2 * 768; e += 512) {
        const int q4 = e % 768, rho = e / 768;
        const int oc = 4 * q4, pn = oc >> 7, j = oc & 127;
        const int ta = pn * 256 + j, tg = ta + 128;
        const float* h0 = HALO + (size_t)(pm * 4) * 6144; const float* hp = HALO + (size_t)((pm - 1) * 4) * 6144;
        const f32x4 x0a = *(const f32x4*)(h0 + ta), x0g = *(const f32x4*)(h0 + tg), x1a = *(const f32x4*)(h0 + 6144 + ta), x1g = *(const f32x4*)(h0 + 6144 + tg);
        const f32x4 m2a = *(const f32x4*)(hp + 2 * 6144 + ta), m2g = *(const f32x4*)(hp + 2 * 6144 + tg), m1a = *(const f32x4*)(hp + 3 * 6144 + ta), m1g = *(const f32x4*)(hp + 3 * 6144 + tg);
        const f32x4 wa0 = *(const f32x4*)(cw + oc), wa1 = *(const f32x4*)(cw + 6144 + oc), wa2 = *(const f32x4*)(cw + 2 * 6144 + oc), ba = *(const f32x4*)(cb + oc);
        const f32x4 wg0 = *(const f32x4*)(cw + 3072 + oc), wg1 = *(const f32x4*)(cw + 6144 + 3072 + oc), wg2 = *(const f32x4*)(cw + 2 * 6144 + 3072 + oc), bg = *(const f32x4*)(cb + 3072 + oc);
        f32x4 ca, cgv;
        if (rho == 0) { ca = ba + wa2 * x0a + wa1 * m1a + wa0 * m2a; cgv = bg + wg2 * x0g + wg1 * m1g + wg0 * m2g; }
        else          { ca = ba + wa2 * x1a + wa1 * x0a + wa0 * m1a; cgv = bg + wg2 * x1g + wg1 * x0g + wg0 * m1g; }
        u32x2 w; w.x = cvt_pk_bf16(gelu_t(ca[0]) * cgv[0], gelu_t(ca[1]) * cgv[1]); w.y = cvt_pk_bf16(gelu_t(ca[2]) * cgv[2], gelu_t(ca[3]) * cgv[3]);
        *(u32x2*)(ACT + (size_t)(pm * 256 + rho) * 3072 + oc) = w;
    }
}

__device__ __forceinline__ void final_norm(const bf16* HB, const bf16* HL, float* out, const float* gfin) {
    const int lane = threadIdx.x & 63, wave = threadIdx.x >> 6;
    const int gw = blockIdx.x * NWAVES + wave, NGW = gridDim.x * NWAVES;
    f32x4 gv[4];
#pragma unroll
    for (int j = 0; j < 4; ++j) gv[j] = ((const f32x4*)gfin)[lane + 64 * j];
    for (int m0 = gw; m0 < T; m0 += 2 * NGW) {
        u32x2 hw[2][4], lw[2][4];
#pragma unroll
        for (int q = 0; q < 2; ++q) {
            const int m = (m0 + q * NGW < T) ? m0 + q * NGW : m0;
            const u32x2* hp = (const u32x2*)(HB + (size_t)m * D) + lane; const u32x2* lp = (const u32x2*)(HL + (size_t)m * D) + lane;
#pragma unroll
            for (int j = 0; j < 4; ++j) { hw[q][j] = hp[64 * j]; lw[q][j] = lp[64 * j]; }
        }
#pragma unroll
        for (int q = 0; q < 2; ++q) {
            const int m = m0 + q * NGW; if (m >= T) continue;
            f32x4 v[4]; float s = 0.f;
#pragma unroll
            for (int j = 0; j < 4; ++j) {
                const u32x2 h_ = hw[q][j], l_ = lw[q][j];
                v[j] = (f32x4){bf_lo(h_.x) + bf_lo(l_.x), bf_hi(h_.x) + bf_hi(l_.x), bf_lo(h_.y) + bf_lo(l_.y), bf_hi(h_.y) + bf_hi(l_.y)};
                s += (v[j][0] * v[j][0] + v[j][1] * v[j][1]) + (v[j][2] * v[j][2] + v[j][3] * v[j][3]);
            }
            s = wave_sum(s);
            const float rs = 1.0f / sqrtf(s * (1.0f / 1024.0f) + 1e-6f);
            f32x4* xr = (f32x4*)(out + (size_t)m * D) + lane;
#pragma unroll
            for (int j = 0; j < 4; ++j) xr[64 * j] = v[j] * rs * gv[j];
        }
    }
}

__device__ __forceinline__ void fill_rs_table(LAS float* rsl, const pg8::StaticOrder& S, const float* rowsq) {
    int tid_ = threadIdx.x; asm volatile("" : "+v"(tid_));
    const int r = tid_ & 255, half = tid_ >> 8;
    for (int i0 = 0; i0 < 12; i0 += 2) {
        pg8::Unit uu;
        if (S.next(i0 + half, uu)) rsl[(i0 + half) * 256 + r] = pg8::row_rs(rowsq, uu.pm * 256 + r);
    }
    __syncthreads();
}

#define GSYNC() xcd_barrier(xbar)
__global__ void __launch_bounds__(NWAVES * 64, 2) mega_fwd(Args a) {
    extern __shared__ __attribute__((aligned(16))) unsigned char lds_raw[];
    cg::grid_group grid = cg::this_grid();
    LAS unsigned char* lds = (LAS unsigned char*)lds_raw;
    unsigned char* ws = a.ws;
    bf16* HB = (bf16*)(ws + WS_HB);
    bf16* HL = (bf16*)(ws + WS_HL);
    float* rowsq = (float*)(ws + WS_ROWSQ);
    bf16* B0 = (bf16*)(ws + WS_BIG);
    bf16* B1 = (bf16*)(ws + WS_BIG + 64 * MiB);
    bf16* B2 = (bf16*)(ws + WS_BIG + 128 * MiB);
    const int G = gridDim.x, c = blockIdx.x;

    {
        volatile LAS unsigned* st = (volatile LAS unsigned*)(lds + LDS_BYTES - 64);
        if (threadIdx.x < 16) st[threadIdx.x] = 0u;
        __syncthreads();
    }
    XcdBarrier xbar = xcd_barrier_post((unsigned*)(ws + WS_CTL), (volatile LAS unsigned*)(lds + LDS_BYTES - 64));
    prologue(lds, a);
    xcd_barrier(xbar);
    if (gridDim.y == 0x7fffu) grid.sync();

#pragma unroll 1
    for (int layer = 0; layer < 4; ++layer) {
        const int j = layer >> 1;
        if ((layer & 1) == 0) {
            {
                pg8::Gemm g{HB, (const bf16*)(ws + WS_RG_WIN) + (size_t)j * 2048 * 1024, T, 2048, 1024}; pg8::StaticOrder S; S.init(T, 2048, G, c);
                fill_rs_table((LAS float*)(lds + pg8::STAGE_BYTES + 12288), S, rowsq);
                pg8::EpiRsBf16 E{B0, B1, 4, (LAS const float*)(lds + pg8::STAGE_BYTES + 12288)};
                pg8::gemm_phase<pg8::EpiRsBf16, pg8::StaticOrder, true, true>(lds, g, S, E);
            }
            GSYNC();
            RgP P{B0, B1, B2, (float*)(ws + WS_SUMM), (const bf16*)(ws + WS_GATES) + (size_t)(j * 2 + 0) * 8 * 128 * 128, (const bf16*)(ws + WS_GATES) + (size_t)(j * 2 + 1) * 8 * 128 * 128,
                  a.in[8] + j * 1024, a.in[10] + j * 1024, a.in[11] + j * 1024, a.in[5] + j * 4 * 1024, a.in[6] + j * 1024};
            rg_mixer<0>(lds, P);
            GSYNC();
            rg_mixer<1>(lds, P);
            GSYNC();
            {
                pg8::Gemm g{B2, (const bf16*)(ws + WS_RG_WOUT) + (size_t)j * 1024 * 1024, T, 1024, 1024}; pg8::StaticOrder S; S.init(T, 1024, G, c);
                pg8::EpiResid E{layer == 0 ? a.in[0] : nullptr, HB, HL, rowsq};
                pg8::gemm_phase<pg8::EpiResid, pg8::StaticOrder, true, true>(lds, g, S, E);
            }
            GSYNC();
        } else {
            {
                pg8::Gemm g{HB, (const bf16*)(ws + WS_S5_WIN) + (size_t)j * 1024 * 1024, T, 1024, 1024}; pg8::StaticOrder S; S.init(T, 1024, G, c);
                fill_rs_table((LAS float*)(lds + pg8::STAGE_BYTES + 12288), S, rowsq);
                pg8::EpiRsBf16 E{B0, B0, 4, (LAS const float*)(lds + pg8::STAGE_BYTES + 12288)};
                pg8::gemm_phase<pg8::EpiRsBf16, pg8::StaticOrder, true, true>(lds, g, S, E);
            }
            GSYNC();
            {
                S5P P{B0, B1, (const float*)(ws + WS_ABAR) + (size_t)j * 64 * 64 * 2, (const bf16*)(ws + WS_BBAR) + (size_t)j * 64 * 128 * 16, (const bf16*)(ws + WS_CMAT) + (size_t)j * 64 * 16 * 128, a.in[21] + j * 1024};
                s5_mixer(lds, P);
            }
            GSYNC();
            {
                pg8::Gemm g{B1, (const bf16*)(ws + WS_S5_WGLU) + (size_t)j * 2048 * 1024, T, 2048, 1024}; pg8::StaticOrder S; S.init(T, 2048, G, c);
                pg8::EpiGlu E{B2};
                pg8::gemm_phase<pg8::EpiGlu, pg8::StaticOrder, true, true>(lds, g, S, E);
            }
            GSYNC();
            {
                pg8::Gemm g{B2, (const bf16*)(ws + WS_S5_WOUT) + (size_t)j * 1024 * 1024, T, 1024, 1024}; pg8::StaticOrder S; S.init(T, 1024, G, c);
                pg8::EpiResid E{nullptr, HB, HL, rowsq};
                pg8::gemm_phase<pg8::EpiResid, pg8::StaticOrder, true, true>(lds, g, S, E);
            }
            GSYNC();
        }
        const float* fcw = a.in[25] + (size_t)layer * 3 * 6144; const float* fcb = a.in[26] + (size_t)layer * 6144;
        {
            pg8::Gemm g{HB, (const bf16*)(ws + WS_FFN_WUP) + (size_t)layer * 6144 * 1024, T, 6144, 1024}; pg8::StaticOrder S; S.init(T, 6144, G, c);
            fill_rs_table((LAS float*)(lds + pg8::STAGE_BYTES + 12288), S, rowsq);
            pg8::EpiFfnUp E{B0, (float*)(ws + WS_HALO), rowsq, fcw, fcb, (LAS float*)(lds + pg8::STAGE_BYTES), (LAS float*)(lds + pg8::STAGE_BYTES + 8192)};
            pg8::gemm_phase<pg8::EpiFfnUp, pg8::StaticOrder, true, true>(lds, g, S, E);
        }
        GSYNC();
        {
            pg8::Gemm g{B0, (const bf16*)(ws + WS_FFN_WDN) + (size_t)layer * 1024 * 3072, T, 1024, 3072}; pg8::StaticOrder S; S.init(T, 1024, G, c);
            {
                int tid_ = threadIdx.x; asm volatile("" : "+v"(tid_));
                pg8::Unit uu; int last_pm = -1;
                for (int i = 0; S.next(i, uu); ++i) { if (uu.pm != last_pm) ffn_fixup_panel((const float*)(ws + WS_HALO), fcw, fcb, B0, uu.pm, tid_); last_pm = uu.pm; }
                asm volatile("s_waitcnt vmcnt(0)" ::: "memory");
                __syncthreads();
            }
            pg8::EpiResid E{nullptr, HB, HL, rowsq};
            pg8::gemm_phase<pg8::EpiResid, pg8::StaticOrder, true, true>(lds, g, S, E);
        }
        GSYNC();
    }
    final_norm(HB, HL, a.out, a.in[3]);
}

extern "C" void kernel_launch(void* const* d_in, const int* in_sizes, int n_in, void* d_out, int out_size, void* d_ws, size_t ws_size, hipStream_t stream) {
    static int grid = 0;
    if (grid == 0) {
        if (n_in != 28 || in_sizes[0] != T * D || out_size != T * D || ws_size < WS_END) {
            fprintf(stderr, "kernel_launch: unexpected problem (n_in %d, in0 %d, out %d, ws %zu < %zu)\n", n_in, n_in > 0 ? in_sizes[0] : -1, out_size, ws_size, (size_t)WS_END); grid = -1; return; }
        int dev = 0, cus = 0, per_cu = 0;
        (void)hipGetDevice(&dev);
        (void)hipDeviceGetAttribute(&cus, hipDeviceAttributeMultiprocessorCount, dev);
        if (hipFuncSetAttribute((const void*)mega_fwd, hipFuncAttributeMaxDynamicSharedMemorySize, LDS_BYTES) != hipSuccess) { fprintf(stderr, "kernel_launch: hipFuncSetAttribute failed\n"); grid = -1; return; }
        if (hipOccupancyMaxActiveBlocksPerMultiprocessor(&per_cu, (const void*)mega_fwd, NWAVES * 64, LDS_BYTES) != hipSuccess || per_cu < 1) { fprintf(stderr, "kernel_launch: occupancy query says %d blocks per CU\n", per_cu); (void)hipGetLastError(); per_cu = 1; }
        grid = cus * 1;
        if (grid > 256) grid = 256;
    }
    if (grid < 0) return;
    Args a{};
    for (int i = 0; i < 28; ++i) a.in[i] = (const float*)d_in[i];
    a.out = (float*)d_out; a.ws = (unsigned char*)d_ws;
    void* args[] = {&a};
    if (hipMemsetAsync((char*)d_ws + WS_CTL, 0, CTL_ZERO_BYTES, stream) != hipSuccess) { fprintf(stderr, "kernel_launch: memset of the barrier words failed\n"); return; }
    const hipError_t e = hipLaunchCooperativeKernel((const void*)mega_fwd, dim3(grid), dim3(NWAVES * 64), args, LDS_BYTES, stream);
    if (e != hipSuccess) fprintf(stderr, "kernel_launch: cooperative launch failed: %s (grid %d)\n", hipGetErrorString(e), grid);
}
```
